# Optimizing an MI355X kernel written in HIP

```python
import math
import jax, jax.numpy as jnp
from jax import lax
import numpy as np

D_MODEL = 1024
BATCH = 8
SEQ = 2048
DEPTH = 2

N_A_LAYERS = DEPTH // 2
N_B_LAYERS = DEPTH - N_A_LAYERS
D_FF = 2816
LRU_WIDTH = D_MODEL
LRU_BLOCKS = 4
LRU_BLOCK_WIDTH = LRU_WIDTH // LRU_BLOCKS
CONV_WIDTH = 4
RG_C = 8.0
N_HEADS = 8
QK_DIM = 64
V_DIM = 2 * QK_DIM
KV_WIDTH = N_HEADS * (2 * QK_DIM + V_DIM)
ROPE_THETA = 10000.0
Q_BLOCK = 128
EPS = 1e-6

kernel_name = "yoco_hawk_diffattn_macaron"


def rmsnorm(x, g):
    xf = x.astype(jnp.float32)
    y = xf * lax.rsqrt(jnp.mean(xf * xf, axis=-1, keepdims=True) + EPS)
    return (y * g.astype(jnp.float32)).astype(x.dtype)


def swiglu_ffn(u, w_in, w_out):
    gate, up = jnp.split(u @ w_in, 2, axis=-1)
    return (jax.nn.silu(gate) * up) @ w_out


def rope_tables(seq_len):
    pos = jnp.arange(seq_len, dtype=jnp.float32)
    inv_freq = ROPE_THETA ** (-jnp.arange(0, QK_DIM, 2, dtype=jnp.float32) / QK_DIM)
    ang = pos[:, None] * inv_freq[None, :]
    return jnp.cos(ang), jnp.sin(ang)


def apply_rope(t, cos, sin):
    tf = t.astype(jnp.float32)
    t1, t2 = jnp.split(tf, 2, axis=-1)
    c = cos[None, :, None, :]
    s = sin[None, :, None, :]
    out = jnp.concatenate([t1 * c - t2 * s, t2 * c + t1 * s], axis=-1)
    return out.astype(t.dtype)


def causal_depthwise_conv(x, w, b):
    seq_len = x.shape[1]
    xp = jnp.pad(x, ((0, 0), (CONV_WIDTH - 1, 0), (0, 0)))
    out = b
    for k in range(CONV_WIDTH):
        out = out + xp[:, k:k + seq_len, :] * w[k]
    return out


def _lin_rec_combine(e1, e2):
    a1, b1 = e1
    a2, b2 = e2
    return a1 * a2, a2 * b1 + b2


def rglru_block(u, w_in, b_in, conv_w, conv_b, gate_w, gate_b, lam, w_out, b_out):
    bsz, seq_len, _ = u.shape
    y = u @ w_in + b_in
    gate_branch, xb = jnp.split(y, 2, axis=-1)
    gate_branch = jax.nn.gelu(gate_branch, approximate=True)
    xb = causal_depthwise_conv(xb, conv_w, conv_b)
    xblk = xb.reshape(bsz, seq_len, LRU_BLOCKS, LRU_BLOCK_WIDTH)
    g = jnp.einsum('bsnc,ncg->bsng', xblk, gate_w) + gate_b
    g = jax.nn.sigmoid(g.astype(jnp.float32))
    gate_x = g[..., :LRU_BLOCK_WIDTH].reshape(bsz, seq_len, LRU_WIDTH)
    gate_a = g[..., LRU_BLOCK_WIDTH:].reshape(bsz, seq_len, LRU_WIDTH)
    log_a = RG_C * gate_a * jax.nn.log_sigmoid(lam.astype(jnp.float32))
    a = jnp.exp(log_a)
    mult = jnp.sqrt(-jnp.expm1(2.0 * log_a))
    b = mult * (gate_x * xb.astype(jnp.float32))
    _, h = lax.associative_scan(_lin_rec_combine, (a, b), axis=1)
    return (h.astype(u.dtype) * gate_branch) @ w_out + b_out


def shared_kv(h, kv_norm, w_kv, cos, sin):
    bsz, seq_len, _ = h.shape
    kv = (rmsnorm(h, kv_norm) @ w_kv).reshape(bsz, seq_len, N_HEADS, 2 * QK_DIM + V_DIM)
    k1 = apply_rope(kv[..., :QK_DIM], cos, sin)
    k2 = apply_rope(kv[..., QK_DIM:2 * QK_DIM], cos, sin)
    v = kv[..., 2 * QK_DIM:]
    to_bhsd = lambda t: jnp.transpose(t, (0, 2, 1, 3))
    return to_bhsd(k1), to_bhsd(k2), to_bhsd(v)


def causal_diff_attention(q1, q2, k1, k2, v, lam):
    bsz, n_heads, seq_len, _ = q1.shape
    n_blk = seq_len // Q_BLOCK
    scale = QK_DIM ** -0.5
    kpos = jnp.arange(seq_len, dtype=jnp.int32)
    neg = jnp.finfo(jnp.float32).min

    def to_blocks(q):
        q = q.reshape(bsz, n_heads, n_blk, Q_BLOCK, QK_DIM)
        return jnp.transpose(q, (2, 0, 1, 3, 4))

    def one_block(args):
        q1b, q2b, start = args
        qpos = start + jnp.arange(Q_BLOCK, dtype=jnp.int32)
        mask = kpos[None, :] <= qpos[:, None]
        s1 = jnp.einsum('bhqd,bhkd->bhqk', q1b, k1).astype(jnp.float32) * scale
        s2 = jnp.einsum('bhqd,bhkd->bhqk', q2b, k2).astype(jnp.float32) * scale
        p1 = jax.nn.softmax(jnp.where(mask, s1, neg), axis=-1)
        p2 = jax.nn.softmax(jnp.where(mask, s2, neg), axis=-1)
        p = (p1 - lam * p2).astype(v.dtype)
        return jnp.einsum('bhqk,bhkd->bhqd', p, v)

    starts = jnp.arange(n_blk, dtype=jnp.int32) * Q_BLOCK
    out = lax.map(one_block, (to_blocks(q1), to_blocks(q2), starts))
    out = jnp.transpose(out, (1, 0, 3, 2, 4))
    return out.reshape(bsz, seq_len, n_heads, V_DIM)


def diff_attn_layer(u, k1, k2, v, w_q, lam_params, subln_g, w_o, lambda_init, cos, sin):
    bsz, seq_len, _ = u.shape
    q = (u @ w_q).reshape(bsz, seq_len, N_HEADS, 2, QK_DIM)
    q1 = jnp.transpose(apply_rope(q[..., 0, :], cos, sin), (0, 2, 1, 3))
    q2 = jnp.transpose(apply_rope(q[..., 1, :], cos, sin), (0, 2, 1, 3))
    lp = lam_params.astype(jnp.float32)
    lam = jnp.exp(jnp.sum(lp[0] * lp[1])) - jnp.exp(jnp.sum(lp[2] * lp[3])) + lambda_init
    o = causal_diff_attention(q1, q2, k1, k2, v, lam)
    o = rmsnorm(o, subln_g) * (1.0 - lambda_init)
    return o.reshape(bsz, seq_len, N_HEADS * V_DIM) @ w_o


def setup_inputs(seed: int = 0) -> dict:
    key = jax.random.key(seed)
    ks = jax.random.split(key, 32)
    f32 = jnp.float32
    nrm = lambda k, shape, fan_in: jax.random.normal(k, shape, f32) * (fan_in ** -0.5)
    gain = lambda k, shape: 1.0 + 0.02 * jax.random.normal(k, shape, f32)
    small = lambda k, shape: 0.01 * jax.random.normal(k, shape, f32)
    R = LRU_WIDTH
    u = jax.random.uniform(ks[14], (N_A_LAYERS, R), f32, 0.9, 0.999)
    a0 = u ** (1.0 / RG_C)
    rg_lambda = jnp.log(a0) - jnp.log1p(-a0)
    return {
        "x": jax.random.normal(ks[0], (BATCH, SEQ, D_MODEL), f32),
        "ffn1_norm": gain(ks[1], (DEPTH, D_MODEL)),
        "ffn1_w_in": nrm(ks[2], (DEPTH, D_MODEL, 2 * D_FF), D_MODEL),
        "ffn1_w_out": nrm(ks[3], (DEPTH, D_FF, D_MODEL), D_FF),
        "mix_norm": gain(ks[4], (DEPTH, D_MODEL)),
        "ffn2_norm": gain(ks[5], (DEPTH, D_MODEL)),
        "ffn2_w_in": nrm(ks[6], (DEPTH, D_MODEL, 2 * D_FF), D_MODEL),
        "ffn2_w_out": nrm(ks[7], (DEPTH, D_FF, D_MODEL), D_FF),
        "rg_w_in": nrm(ks[8], (N_A_LAYERS, D_MODEL, 2 * R), D_MODEL),
        "rg_b_in": small(ks[9], (N_A_LAYERS, 2 * R)),
        "rg_conv_w": nrm(ks[10], (N_A_LAYERS, CONV_WIDTH, R), CONV_WIDTH),
        "rg_conv_b": small(ks[11], (N_A_LAYERS, R)),
        "rg_gate_w": nrm(ks[12], (N_A_LAYERS, LRU_BLOCKS, LRU_BLOCK_WIDTH, 2 * LRU_BLOCK_WIDTH), LRU_BLOCK_WIDTH),
        "rg_gate_b": small(ks[13], (N_A_LAYERS, LRU_BLOCKS, 2 * LRU_BLOCK_WIDTH)),
        "rg_lambda": rg_lambda,
        "rg_w_out": nrm(ks[15], (N_A_LAYERS, R, D_MODEL), R),
        "rg_b_out": small(ks[16], (N_A_LAYERS, D_MODEL)),
        "kv_norm": gain(ks[17], (D_MODEL,)),
        "w_kv": nrm(ks[18], (D_MODEL, KV_WIDTH), D_MODEL),
        "diff_w_q": nrm(ks[19], (N_B_LAYERS, D_MODEL, N_HEADS * 2 * QK_DIM), D_MODEL),
        "diff_lambda": 0.1 * jax.random.normal(ks[20], (N_B_LAYERS, 4, QK_DIM), f32),
        "diff_subln": gain(ks[21], (N_B_LAYERS, V_DIM)),
        "diff_w_o": nrm(ks[22], (N_B_LAYERS, N_HEADS * V_DIM, D_MODEL), N_HEADS * V_DIM),
        "final_norm": gain(ks[23], (D_MODEL,)),
    }


def reference(x, ffn1_norm, ffn1_w_in, ffn1_w_out, mix_norm, ffn2_norm, ffn2_w_in, ffn2_w_out,
              rg_w_in, rg_b_in, rg_conv_w, rg_conv_b, rg_gate_w, rg_gate_b, rg_lambda, rg_w_out, rg_b_out,
              kv_norm, w_kv, diff_w_q, diff_lambda, diff_subln, diff_w_o, final_norm):
    seq_len = x.shape[1]
    cos, sin = rope_tables(seq_len)
    h = x
    k1 = k2 = v = None
    for l in range(DEPTH):
        if l == N_A_LAYERS:
            k1, k2, v = shared_kv(h, kv_norm, w_kv, cos, sin)
        h = h + 0.5 * swiglu_ffn(rmsnorm(h, ffn1_norm[l]), ffn1_w_in[l], ffn1_w_out[l])
        u = rmsnorm(h, mix_norm[l])
        if l < N_A_LAYERS:
            h = h + rglru_block(u, rg_w_in[l], rg_b_in[l], rg_conv_w[l], rg_conv_b[l],
                                rg_gate_w[l], rg_gate_b[l], rg_lambda[l], rg_w_out[l], rg_b_out[l])
        else:
            j = l - N_A_LAYERS
            lambda_init = 0.8 - 0.6 * math.exp(-0.3 * l)
            h = h + diff_attn_layer(u, k1, k2, v, diff_w_q[j], diff_lambda[j], diff_subln[j],
                                    diff_w_o[j], lambda_init, cos, sin)
        h = h + 0.5 * swiglu_ffn(rmsnorm(h, ffn2_norm[l]), ffn2_w_in[l], ffn2_w_out[l])
    return rmsnorm(h, final_norm)
```

```cpp
#include <hip/hip_runtime.h>
#include <hip/hip_cooperative_groups.h>
#include <hip/hip_bf16.h>
#include <cstdio>
#include <cstdint>
#include <cmath>
#ifndef EN_SWI
#define EN_SWI 1
#endif
#ifndef EN_RES
#define EN_RES 1
#endif
#ifndef EN_KV
#define EN_KV 1
#endif
#ifndef EN_RGIN
#define EN_RGIN 1
#endif
#ifndef EN_GATE
#define EN_GATE 1
#endif
#ifndef EN_Q
#define EN_Q 1
#endif
#ifndef EN_P0
#define EN_P0 1
#endif
#ifndef EN_RGM
#define EN_RGM 1
#endif
#ifndef EN_COMB
#define EN_COMB 1
#endif
#ifndef EN_NORM
#define EN_NORM 1
#endif
#ifndef PROBE
#define PROBE 0
#endif
#define XBAR() do { xcd_barrier(bar); if (PROBE == 6) xcd_barrier(bar); } while (0)
#ifndef EN_ATT
#define EN_ATT 1
#endif
namespace pg8 {
#define PG8_LAS __attribute__((address_space(3)))
typedef unsigned short bf16_t;
typedef short bf16x8 __attribute__((ext_vector_type(8)));
typedef float f32x4 __attribute__((ext_vector_type(4)));
typedef unsigned u32x4 __attribute__((ext_vector_type(4)));
constexpr int BM = 256, BK = 64, HALF = 128, HTB = HALF * BK * 2  , STAGE_BYTES = 8 * HTB, NXCD = 8, WGM = 8;

__host__ __device__ __forceinline__ int lds_byte(int r, int c) { const int st = (r >> 4) * 2 + (c >> 5), rr = r & 15, cc = c & 31, ob = rr * 64 + cc * 2; return st * 1024 + (ob ^ (((ob >> 9) & 1) << 5)); }
__host__ __device__ __forceinline__ void stage_rc(int b, int& R, int& C) { const int st = b / 1024, sb = b % 1024, swz = sb ^ (((sb >> 9) & 1) << 5); R = (st >> 1) * 16 + swz / 64; C = (st & 1) * 32 + (swz % 64) / 2; }
__host__ __device__ __forceinline__ int perm32(int rho) { const int n = rho >> 4, i = rho & 15; return 8 * (i >> 2) + 4 * n + (i & 3); }

struct Unit { int pm, pn; };
struct Gemm { const bf16_t* A; const bf16_t* Bt; int M, N, K, lda, ldb, ash, abytes; };

struct StaticOrder {
    int nM, nN, nwg, G, c;
    __host__ __device__ __forceinline__ void init(int M, int N, int G_, int c_) { nM = M / BM; nN = N / BM; nwg = nM * nN; G = G_; c = c_; }
    __host__ __device__ __forceinline__ bool next(int i, Unit& u) const {
        const long L = (long)i * G + c; if (L >= nwg) return false;
        int wgid = (int)L; { const int q = nwg / NXCD, r = nwg % NXCD, xcd = wgid % NXCD, off = wgid / NXCD; wgid = (xcd < r ? xcd * (q + 1) : r * (q + 1) + (xcd - r) * q) + off; }
        const int nig = WGM * nN, gid = wgid / nig, fm = gid * WGM, gsz = (nM - fm) < WGM ? (nM - fm) : WGM;
        u.pm = fm + ((wgid % nig) % gsz); u.pn = (wgid % nig) / gsz; return true;
    }
    __device__ __forceinline__ void a_ready(const Unit&) const {}
    __device__ __forceinline__ void done(const Unit&) const {}
};
struct GateOrder { StaticOrder S;
    __host__ __device__ __forceinline__ void init(int M, int G_, int c_) { S.init(M, 1024, G_, c_); }
    __host__ __device__ __forceinline__ bool next(int i, Unit& u) const { Unit t; if (!S.next(i >> 1, t)) return false; u.pm = t.pm; u.pn = 2 * t.pn + (i & 1); return true; }
    __device__ __forceinline__ void a_ready(const Unit&) const {}
    __device__ __forceinline__ void done(const Unit&) const {}
};


__device__ __forceinline__ unsigned cvt_pk_bf16(float lo, float hi) { unsigned r; asm volatile("v_cvt_pk_bf16_f32 %0, %1, %2" : "=v"(r) : "v"(lo), "v"(hi)); return r; }
__device__ __forceinline__ u32x4 pack8(const f32x4 a, const f32x4 b) { u32x4 w; w.x = cvt_pk_bf16(a[0], a[1]); w.y = cvt_pk_bf16(a[2], a[3]); w.z = cvt_pk_bf16(b[0], b[1]); w.w = cvt_pk_bf16(b[2], b[3]); return w; }
__device__ __forceinline__ float fexp(float x) { return __builtin_amdgcn_exp2f(x * 1.4426950408889634f); }
__device__ __forceinline__ float fsigmoid(float x) { return __builtin_amdgcn_rcpf(1.0f + fexp(-x)); }
__device__ __forceinline__ float rs_row(const float* ss, int row, int fq) { const f32x4 p = *(const f32x4*)(ss + (size_t)row * 16 + 4 * fq); float t = (p[0] + p[1]) + (p[2] + p[3]);
    t += __shfl_xor(t, 16); t += __shfl_xor(t, 32); return __builtin_amdgcn_rsqf(t * (1.0f / 1024.0f) + 1e-6f); }
struct RowScale { const float* ss; const PG8_LAS float* rtab; int rpm;
    __device__ __forceinline__ float get(int pm, int row, int fq) const { return (pm == rpm) ? rtab[row & 255] : rs_row(ss, row, fq); } };
__device__ __forceinline__ float bf_lo(unsigned w) { return __uint_as_float(w << 16); }
__device__ __forceinline__ float bf_hi(unsigned w) { return __uint_as_float(w & 0xffff0000u); }

struct EpiSwiglu {
    static constexpr bool PERM = true, AFTER_DRAIN = false;
    bf16_t* O; int ldc; RowScale rs;
    __device__ __forceinline__ void operator()(const f32x4 (&acc)[2][2][4][2], const Unit& u, int wr, int wc, int fr, int fq) const {
        const int row0 = u.pm * BM + wr * 64 + fr, col0 = u.pn * HALF + wc * 32 + 8 * fq;
#pragma unroll
        for (int ai = 0; ai < 2; ++ai)
#pragma unroll
            for (int m = 0; m < 4; ++m) {
                const int row = row0 + ai * HALF + m * 16; bf16_t* p = O + (size_t)row * ldc + col0;
                const float r = rs.get(u.pm, row, fq), c1 = -1.4426950408889634f * r, c2 = r * r;
                f32x4 v0, v1;
                { const f32x4 g0 = acc[ai][0][m][0], g1 = acc[ai][0][m][1], x0 = g0 * c1, x1 = g1 * c1; f32x4 e0, e1;
#pragma unroll
                  for (int i = 0; i < 4; ++i) { e0[i] = __builtin_amdgcn_exp2f(x0[i]); e1[i] = __builtin_amdgcn_exp2f(x1[i]); }
                  const f32x4 d0 = e0 + 1.0f, d1 = e1 + 1.0f; f32x4 q0, q1;
#pragma unroll
                  for (int i = 0; i < 4; ++i) { q0[i] = __builtin_amdgcn_rcpf(d0[i]); q1[i] = __builtin_amdgcn_rcpf(d1[i]); }
                  v0 = (g0 * acc[ai][1][m][0]) * (q0 * c2); v1 = (g1 * acc[ai][1][m][1]) * (q1 * c2); }
                *(u32x4*)p = pack8(v0, v1);
            }
    }
};
struct EpiCheap {
    static constexpr bool PERM = true, AFTER_DRAIN = false;
    bf16_t* O; int ldc;
    __device__ __forceinline__ void operator()(const f32x4 (&acc)[2][2][4][2], const Unit& u, int wr, int wc, int fr, int fq) const {
        const int row0 = u.pm * BM + wr * 64 + fr, col0 = u.pn * HALF + wc * 32 + 8 * fq;
#pragma unroll
        for (int ai = 0; ai < 2; ++ai)
#pragma unroll
            for (int m = 0; m < 4; ++m) { bf16_t* p = O + (size_t)(row0 + ai * HALF + m * 16) * ldc + col0; *(u32x4*)p = pack8(acc[ai][0][m][0] + acc[ai][1][m][0], acc[ai][0][m][1] + acc[ai][1][m][1]); }
    }
};
struct EpiResid {
    static constexpr bool PERM = true, AFTER_DRAIN = false;
    bf16_t* xb; const float* bias; float scale; float* ss;
    __device__ __forceinline__ void operator()(const f32x4 (&acc)[2][2][4][2], const Unit& u, int wr, int wc, int fr, int fq) const {
        const int row0 = u.pm * BM + wr * 64 + fr, col0 = u.pn * BM + wc * 32 + 8 * fq;
        f32x4 bv[2][2];
#pragma unroll
        for (int bj = 0; bj < 2; ++bj)
#pragma unroll
            for (int n = 0; n < 2; ++n) bv[bj][n] = bias ? *(const f32x4*)(bias + col0 + bj * HALF + 4 * n) : (f32x4){0.f, 0.f, 0.f, 0.f};
#pragma unroll
        for (int ai = 0; ai < 2; ++ai)
#pragma unroll
            for (int m = 0; m < 4; ++m) { const int row = row0 + ai * HALF + m * 16; bf16_t* p = xb + (size_t)row * 1024 + col0; float sq = 0.f;
#pragma unroll
                for (int bj = 0; bj < 2; ++bj) { const u32x4 w = *(const u32x4*)(p + bj * HALF);
                    const f32x4 o0 = (f32x4){bf_lo(w.x), bf_hi(w.x), bf_lo(w.y), bf_hi(w.y)} + (acc[ai][bj][m][0] + bv[bj][0]) * scale;
                    const f32x4 o1 = (f32x4){bf_lo(w.z), bf_hi(w.z), bf_lo(w.w), bf_hi(w.w)} + (acc[ai][bj][m][1] + bv[bj][1]) * scale;
                    sq += ((o0[0] * o0[0] + o0[1] * o0[1]) + (o0[2] * o0[2] + o0[3] * o0[3])) + ((o1[0] * o1[0] + o1[1] * o1[1]) + (o1[2] * o1[2] + o1[3] * o1[3]));
                    *(u32x4*)(p + bj * HALF) = pack8(o0, o1); }
                if (ss) { sq += __shfl_xor(sq, 16); sq += __shfl_xor(sq, 32); if (fq == 0) ss[(size_t)row * 16 + u.pn * 4 + wc] = sq; }
            }
    }
};
struct EpiRgIn {
    static constexpr bool PERM = true, AFTER_DRAIN = false;
    bf16_t* GB; bf16_t* XPRE; const float* bias; RowScale rs;
    __device__ __forceinline__ void operator()(const f32x4 (&acc)[2][2][4][2], const Unit& u, int wr, int wc, int fr, int fq) const {
        const int row0 = u.pm * BM + wr * 64 + fr, colg = u.pn * BM + wc * 32 + 8 * fq;
        const bool isg = u.pn < 4; bf16_t* dst = isg ? GB : XPRE; const int cold = isg ? colg : colg - 1024;
        f32x4 bv[2][2];
#pragma unroll
        for (int bj = 0; bj < 2; ++bj)
#pragma unroll
            for (int n = 0; n < 2; ++n) bv[bj][n] = *(const f32x4*)(bias + colg + bj * HALF + 4 * n);
#pragma unroll
        for (int ai = 0; ai < 2; ++ai)
#pragma unroll
            for (int m = 0; m < 4; ++m) { const int row = row0 + ai * HALF + m * 16; bf16_t* rowp = dst + (size_t)row * 1024 + cold; const float r = rs.get(u.pm, row, fq);
#pragma unroll
                for (int bj = 0; bj < 2; ++bj) { f32x4 v0 = acc[ai][bj][m][0] * r + bv[bj][0], v1 = acc[ai][bj][m][1] * r + bv[bj][1];
                    if (isg) {
#pragma unroll
                        for (int i = 0; i < 4; ++i) { const float a = v0[i], b = v1[i]; v0[i] = a * fsigmoid(1.5957691216057308f * (a + 0.044715f * a * a * a)); v1[i] = b * fsigmoid(1.5957691216057308f * (b + 0.044715f * b * b * b)); } }
                    *(u32x4*)(rowp + bj * HALF) = pack8(v0, v1); } }
    }
};
struct EpiGate {
    static constexpr bool PERM = true, AFTER_DRAIN = false;
    const bf16_t* XBC; const float* gate_b; const float* c8; bf16_t* LAout; bf16_t* Bout;
    __device__ __forceinline__ void operator()(const f32x4 (&acc)[2][2][4][2], const Unit& u, int wr, int wc, int fr, int fq) const {
        const int row0 = u.pm * BM + wr * 64 + fr, grp = u.pn >> 1, chl = (u.pn & 1) * HALF + wc * 32 + 8 * fq, ch0 = grp * 256 + chl;
        f32x4 bxl[2], bal[2], cc[2];
#pragma unroll
        for (int n = 0; n < 2; ++n) { bxl[n] = *(const f32x4*)(gate_b + grp * 512 + chl + 4 * n) * -1.4426950408889634f; bal[n] = *(const f32x4*)(gate_b + grp * 512 + 256 + chl + 4 * n) * -1.4426950408889634f; cc[n] = *(const f32x4*)(c8 + ch0 + 4 * n); }
#pragma unroll
        for (int ai = 0; ai < 2; ++ai)
#pragma unroll
            for (int m = 0; m < 4; ++m) { const size_t off = (size_t)(row0 + ai * HALF + m * 16) * 1024 + ch0;
                const u32x4 xw = *(const u32x4*)(XBC + off);
                f32x4 xv[2]; xv[0] = (f32x4){bf_lo(xw.x), bf_hi(xw.x), bf_lo(xw.y), bf_hi(xw.y)}; xv[1] = (f32x4){bf_lo(xw.z), bf_hi(xw.z), bf_lo(xw.w), bf_hi(xw.w)};
                f32x4 lv[2], bo[2];
#pragma unroll
                for (int n = 0; n < 2; ++n)
#pragma unroll
                    for (int i = 0; i < 4; ++i) {
                        const float gx = __builtin_amdgcn_rcpf(1.0f + __builtin_amdgcn_exp2f(__builtin_fmaf(acc[ai][0][m][n][i], -1.4426950408889634f, bxl[n][i])));
                        const float ga = __builtin_amdgcn_rcpf(1.0f + __builtin_amdgcn_exp2f(__builtin_fmaf(acc[ai][1][m][n][i], -1.4426950408889634f, bal[n][i])));
                        const float la = cc[n][i] * ga, em = __builtin_fmaxf(1.0f - __builtin_amdgcn_exp2f(la * 2.8853900817779268f), 0.0f);
                        lv[n][i] = la; bo[n][i] = __builtin_amdgcn_sqrtf(em) * (gx * xv[n][i]); }
                *(u32x4*)(LAout + off) = pack8(lv[0], lv[1]); *(u32x4*)(Bout + off) = pack8(bo[0], bo[1]);
                if (m & 1) asm volatile("" ::: "memory"); }
    }
};
struct EpiKV {
    static constexpr bool PERM = true, AFTER_DRAIN = false;
    bf16_t* KV; const float* cosT; const float* sinT; RowScale rs;
    __device__ __forceinline__ void operator()(const f32x4 (&acc)[2][2][4][2], const Unit& u, int wr, int wc, int fr, int fq) const {
        const int row0 = u.pm * BM + wr * 64 + fr;
        if (wc < 2) {
            const int ocol = u.pn * 256 + wc * 64 + 8 * fq;
#pragma unroll
            for (int ai = 0; ai < 2; ++ai)
#pragma unroll
                for (int m = 0; m < 4; ++m) { const int row = row0 + ai * HALF + m * 16, pos = row & 2047; const float r = rs.get(u.pm, row, fq);
                    f32x4 o1[2], o2[2];
#pragma unroll
                    for (int n = 0; n < 2; ++n) { const f32x4 c = *(const f32x4*)(cosT + pos * 32 + 8 * fq + 4 * n) * r, s = *(const f32x4*)(sinT + pos * 32 + 8 * fq + 4 * n) * r;
                        const f32x4 x1 = acc[ai][0][m][n], x2 = acc[ai][1][m][n]; o1[n] = x1 * c - x2 * s; o2[n] = x2 * c + x1 * s; }
                    bf16_t* p = KV + (size_t)row * 2048 + ocol; *(u32x4*)p = pack8(o1[0], o1[1]); *(u32x4*)(p + 32) = pack8(o2[0], o2[1]); }
        } else {
            const int ocol = u.pn * 256 + 128 + (wc - 2) * 32 + 8 * fq;
#pragma unroll
            for (int ai = 0; ai < 2; ++ai)
#pragma unroll
                for (int m = 0; m < 4; ++m) { const int row = row0 + ai * HALF + m * 16; bf16_t* p = KV + (size_t)row * 2048 + ocol; const float r = rs.get(u.pm, row, fq);
                    *(u32x4*)p = pack8(acc[ai][0][m][0] * r, acc[ai][0][m][1] * r); *(u32x4*)(p + 64) = pack8(acc[ai][1][m][0] * r, acc[ai][1][m][1] * r); }
        }
    }
};
struct EpiQ {
    static constexpr bool PERM = true, AFTER_DRAIN = false;
    bf16_t* Q; const float* cosT; const float* sinT; float scale; RowScale rs;
    __device__ __forceinline__ void operator()(const f32x4 (&acc)[2][2][4][2], const Unit& u, int wr, int wc, int fr, int fq) const {
        const int row0 = u.pm * BM + wr * 64 + fr, ocol = u.pn * 256 + wc * 64 + 8 * fq;
#pragma unroll
        for (int ai = 0; ai < 2; ++ai)
#pragma unroll
            for (int m = 0; m < 4; ++m) { const int row = row0 + ai * HALF + m * 16, pos = row & 2047; const float rsc = rs.get(u.pm, row, fq) * scale;
                f32x4 o1[2], o2[2];
#pragma unroll
                for (int n = 0; n < 2; ++n) { const f32x4 c = *(const f32x4*)(cosT + pos * 32 + 8 * fq + 4 * n) * rsc, s = *(const f32x4*)(sinT + pos * 32 + 8 * fq + 4 * n) * rsc;
                    const f32x4 x1 = acc[ai][0][m][n], x2 = acc[ai][1][m][n]; o1[n] = x1 * c - x2 * s; o2[n] = x2 * c + x1 * s; }
                bf16_t* p = Q + (size_t)row * 1024 + ocol; *(u32x4*)p = pack8(o1[0], o1[1]); *(u32x4*)(p + 32) = pack8(o2[0], o2[1]); }
    }
};

template <class Epi, class Sched, bool ALIGN_EPI = false, bool SP2 = false>
__device__ __forceinline__ void gemm_phase(PG8_LAS unsigned char* lds, const Gemm g, const Sched& S, const Epi& E) {
    int tid = threadIdx.x; asm volatile("" : "+v"(tid));
    const int wid = __builtin_amdgcn_readfirstlane(tid >> 6), lane = tid & 63, wr = wid >> 2, wc = wid & 3, fr = lane & 15, fq = lane >> 4;
    const int K = g.K, nt = K / BK;
    unsigned voffA[2], voffB[2];
#pragma unroll
    for (int i = 0; i < 2; ++i) { int R, C; stage_rc(tid * 16 + i * 8192, R, C); const int Rb = Epi::PERM ? ((R & ~31) + perm32(R & 31)) : R;
        voffA[i] = (unsigned)(R * g.lda + C) * 2u; voffB[i] = (unsigned)(Rb * g.ldb + C) * 2u; }
    const size_t kstep = (size_t)(BK * 2);
    const size_t hstepA = (size_t)HALF * g.lda * 2, hstepB = (size_t)HALF * g.ldb * 2;
    const size_t tstepA = 2 * hstepA, tstepB = 2 * hstepB;
    const unsigned ldsw = (unsigned)wid * 1024u;
    const int aoff = lds_byte(wr * 64 + fr, fq * 8), boff = lds_byte(wc * 32 + fr, fq * 8);
#define PG8_SA(b, h) (((b) * 2 + (h)) * HTB)
#define PG8_SB(b, h) ((4 + (b) * 2 + (h)) * HTB)
#define PG8_STAGE(bufoff, gbase, voff) do { _Pragma("unroll") for (int _i = 0; _i < 2; ++_i) \
        __builtin_amdgcn_global_load_lds((const unsigned*)((const char*)(gbase) + (voff)[_i]), (PG8_LAS unsigned*)(lds + (bufoff) + ldsw + _i * 8192), 16, 0, 0); } while (0)
#define PG8_LDA(dst, b, h) do { _Pragma("unroll") for (int m = 0; m < 4; ++m) _Pragma("unroll") for (int k = 0; k < 2; ++k) dst[m][k] = *(const PG8_LAS bf16x8*)(lds + PG8_SA(b, h) + aoff + m * 2048 + k * 1024); } while (0)
#define PG8_LDB(dst, b, h) do { _Pragma("unroll") for (int n = 0; n < 2; ++n) _Pragma("unroll") for (int k = 0; k < 2; ++k) dst[n][k] = *(const PG8_LAS bf16x8*)(lds + PG8_SB(b, h) + boff + n * 2048 + k * 1024); } while (0)
#define PG8_MMA(ai, bj, At, Bt) do { __builtin_amdgcn_s_setprio(1); _Pragma("unroll") for (int m = 0; m < 4; ++m) _Pragma("unroll") for (int n = 0; n < 2; ++n) _Pragma("unroll") for (int k = 0; k < 2; ++k) \
        acc[ai][bj][m][n] = __builtin_amdgcn_mfma_f32_16x16x32_bf16(Bt[n][k], At[m][k], acc[ai][bj][m][n], 0, 0, 0); __builtin_amdgcn_s_setprio(0); } while (0)
#define PG8_WAIT_V(n) asm volatile("s_waitcnt vmcnt(" #n ")" ::: "memory")
#define PG8_WAIT_L(n) asm volatile("s_waitcnt lgkmcnt(" #n ")" ::: "memory")
#define PG8_BAR __builtin_amdgcn_s_barrier()
#define PG8_SCHED __builtin_amdgcn_sched_barrier(0)
    Unit cur, nxt; int ui = 0;
    if (!S.next(0, cur)) return;
    f32x4 acc[2][2][4][2];
#pragma unroll
    for (int a = 0; a < 2; ++a)
#pragma unroll
        for (int b = 0; b < 2; ++b)
#pragma unroll
            for (int m = 0; m < 4; ++m)
#pragma unroll
                for (int n = 0; n < 2; ++n) acc[a][b][m][n] = (f32x4){0.f, 0.f, 0.f, 0.f};
    bf16x8 At[4][2], B0[2][2], B1[2][2];
    const char* cA = (const char*)g.A + (size_t)cur.pm * tstepA + (size_t)(cur.pn >> g.ash) * g.abytes; const char* cB = (const char*)g.Bt + (size_t)cur.pn * tstepB;
    S.a_ready(cur);
    if constexpr (SP2) {
        PG8_STAGE(PG8_SB(0, 0), cB, voffB); PG8_STAGE(PG8_SB(0, 1), cB + hstepB, voffB); PG8_STAGE(PG8_SA(0, 0), cA, voffA); PG8_STAGE(PG8_SA(0, 1), cA + hstepA, voffA);
        if (wr == 1) PG8_BAR;
        PG8_WAIT_V(2); PG8_BAR;
        PG8_STAGE(PG8_SB(1, 0), cB + kstep, voffB); PG8_STAGE(PG8_SA(1, 0), cA + kstep, voffA); PG8_STAGE(PG8_SB(1, 1), cB + hstepB + kstep, voffB);
        PG8_WAIT_V(6); PG8_BAR;
    } else {
        PG8_STAGE(PG8_SB(0, 0), cB, voffB); PG8_STAGE(PG8_SA(0, 0), cA, voffA); PG8_STAGE(PG8_SB(0, 1), cB + hstepB, voffB); PG8_STAGE(PG8_SA(0, 1), cA + hstepA, voffA);
        if (wr == 1) PG8_BAR;
        PG8_WAIT_V(4); PG8_BAR;
        PG8_STAGE(PG8_SB(1, 0), cB + kstep, voffB); PG8_STAGE(PG8_SA(1, 0), cA + kstep, voffA); PG8_STAGE(PG8_SB(1, 1), cB + hstepB + kstep, voffB);
        PG8_WAIT_V(6); PG8_BAR;
    }
    for (;;) {
        const bool has_next = S.next(ui + 1, nxt);
        const char* nA = has_next ? (const char*)g.A + (size_t)nxt.pm * tstepA + (size_t)(nxt.pn >> g.ash) * g.abytes : cA; const char* nB = has_next ? (const char*)g.Bt + (size_t)nxt.pn * tstepB : cB;
#pragma unroll 1
        for (int t = 0; t < nt; t += 2) {
            const bool last = (t == nt - 2);
            const char* a1 = cA + (size_t)(t + 1) * kstep;
            const char* a2 = last ? nA : cA + (size_t)(t + 2) * kstep; const char* b2 = last ? nB : cB + (size_t)(t + 2) * kstep;
            const char* a3 = a2 + kstep; const char* b3 = b2 + kstep;
            if (last && has_next) S.a_ready(nxt);
            if constexpr (SP2) {
            PG8_LDB(B0, 0, 0); PG8_LDB(B1, 0, 1); PG8_SCHED; PG8_LDA(At, 0, 0); PG8_STAGE(PG8_SA(1, 1), a1 + hstepA, voffA);
            PG8_WAIT_V(8); PG8_WAIT_L(0); PG8_BAR; PG8_MMA(0, 0, At, B0); PG8_MMA(0, 1, At, B1); PG8_BAR; PG8_SCHED;
            PG8_LDA(At, 0, 1); PG8_STAGE(PG8_SB(0, 0), b2, voffB); PG8_STAGE(PG8_SB(0, 1), b2 + hstepB, voffB); PG8_STAGE(PG8_SA(0, 0), a2, voffA);
            PG8_WAIT_V(8); PG8_WAIT_L(0); PG8_BAR; PG8_MMA(1, 0, At, B0); PG8_MMA(1, 1, At, B1); PG8_BAR; PG8_SCHED;
            PG8_LDB(B0, 1, 0); PG8_LDB(B1, 1, 1); PG8_SCHED; PG8_LDA(At, 1, 0); PG8_STAGE(PG8_SA(0, 1), a2 + hstepA, voffA);
            PG8_WAIT_V(8); PG8_WAIT_L(0); PG8_BAR; PG8_MMA(0, 0, At, B0); PG8_MMA(0, 1, At, B1); PG8_BAR; PG8_SCHED;
            PG8_LDA(At, 1, 1); PG8_STAGE(PG8_SB(1, 0), b3, voffB); PG8_STAGE(PG8_SB(1, 1), b3 + hstepB, voffB); PG8_STAGE(PG8_SA(1, 0), a3, voffA);
            PG8_WAIT_V(8); PG8_WAIT_L(0); PG8_BAR; PG8_MMA(1, 0, At, B0); PG8_MMA(1, 1, At, B1); PG8_BAR; PG8_SCHED;
            } else {
            PG8_LDB(B0, 0, 0); PG8_SCHED; PG8_LDA(At, 0, 0); PG8_STAGE(PG8_SA(1, 1), a1 + hstepA, voffA);
            PG8_WAIT_L(8); PG8_BAR; PG8_WAIT_L(0); PG8_MMA(0, 0, At, B0); PG8_BAR; PG8_SCHED;
            PG8_LDB(B1, 0, 1); PG8_STAGE(PG8_SB(0, 0), b2, voffB);
            PG8_BAR; PG8_WAIT_L(0); PG8_MMA(0, 1, At, B1); PG8_BAR;
            PG8_LDA(At, 0, 1); PG8_STAGE(PG8_SA(0, 0), a2, voffA);
            PG8_BAR; PG8_WAIT_L(0); PG8_MMA(1, 0, At, B0); PG8_BAR; PG8_SCHED;
            PG8_STAGE(PG8_SB(0, 1), b2 + hstepB, voffB);
            PG8_WAIT_V(6); PG8_BAR; PG8_MMA(1, 1, At, B1); PG8_BAR;
            PG8_LDB(B0, 1, 0); PG8_SCHED; PG8_LDA(At, 1, 0); PG8_STAGE(PG8_SA(0, 1), a2 + hstepA, voffA);
            PG8_WAIT_L(8); PG8_BAR; PG8_WAIT_L(0); PG8_MMA(0, 0, At, B0); PG8_BAR; PG8_SCHED;
            PG8_LDB(B1, 1, 1); PG8_STAGE(PG8_SB(1, 0), b3, voffB);
            PG8_BAR; PG8_WAIT_L(0); PG8_MMA(0, 1, At, B1); PG8_BAR;
            PG8_LDA(At, 1, 1); PG8_STAGE(PG8_SA(1, 0), a3, voffA);
            PG8_BAR; PG8_WAIT_L(0); PG8_MMA(1, 0, At, B0); PG8_BAR; PG8_SCHED;
            PG8_STAGE(PG8_SB(1, 1), b3 + hstepB, voffB);
            PG8_WAIT_V(6); PG8_BAR; PG8_MMA(1, 1, At, B1); PG8_BAR;
            }
        }
        if constexpr (ALIGN_EPI) { if (wr == 0) PG8_BAR; }
        if constexpr (!Epi::AFTER_DRAIN) { E(acc, cur, wr, wc, fr, fq); S.done(cur); }
        if (!has_next) break;
#pragma unroll
        for (int a = 0; a < 2; ++a)
#pragma unroll
            for (int b = 0; b < 2; ++b)
#pragma unroll
                for (int m = 0; m < 4; ++m)
#pragma unroll
                    for (int n = 0; n < 2; ++n) acc[a][b][m][n] = (f32x4){0.f, 0.f, 0.f, 0.f};
        cur = nxt; cA = nA; cB = nB; ++ui;
        if constexpr (ALIGN_EPI) { if (wr == 1) PG8_BAR; }
    }
    PG8_WAIT_V(0);
    if constexpr (!ALIGN_EPI) { if (wr == 0) PG8_BAR; }
    PG8_BAR;
    if constexpr (Epi::AFTER_DRAIN) { E.fused(acc, cur, wr, wc, fr, fq, lds, wid, lane); S.done(cur); }
#undef PG8_SA
#undef PG8_SB
#undef PG8_STAGE
#undef PG8_LDA
#undef PG8_LDB
#undef PG8_MMA
#undef PG8_WAIT_V
#undef PG8_WAIT_L
#undef PG8_BAR
#undef PG8_SCHED
}
}

namespace attn_body {
using bf16=__hip_bfloat16;
using bf16x8=__attribute__((ext_vector_type(8)))short;
using s16x4=__attribute__((ext_vector_type(4)))short;
using f32x16=__attribute__((ext_vector_type(16)))float;
using u32x4=__attribute__((ext_vector_type(4)))unsigned;
constexpr int SEQ=2048,D=64,QP=1024,KP=2048,OP=2048;
constexpr int NW=8,QBLK=32,QB=QBLK*NW,KVBLK=64,NQB=SEQ/QB;
constexpr int ATTN_UNIT_ROWS=QB;
__device__ __forceinline__ int crow(int r,int hi){return (r&3)+8*(r>>2)+4*hi;}
#define SBAR() __builtin_amdgcn_sched_barrier(0)
__device__ __forceinline__ void cmask(f32x16&p0,f32x16&p1,int jb,int qrel,int hi){
  const float NEG=-INFINITY; int kb=64*jb+4*hi;
  #pragma unroll
  for(int r=0;r<16;++r){int kv=kb+(r&3)+8*(r>>2); if(kv>qrel)p0[r]=NEG; if(kv+32>qrel)p1[r]=NEG;}
}

constexpr int NSLOT=3, SLOTB=8192;
constexpr int LDS_K=0, LDS_V=NSLOT*SLOTB, LDS_WS=2*NSLOT*SLOTB, LDS_OST=LDS_WS+NW*64*4, LDS_BYTES=LDS_OST+NW*4096;
constexpr float C2=0.125f*1.4426950408889634f;
__device__ __forceinline__ void glds16(const void*gsrc,unsigned lds_dst){unsigned keep;
  asm volatile("s_mov_b32 %0, m0\n\ts_mov_b32 m0, %2\n\ts_nop 0\n\tglobal_load_lds_dwordx4 %1, off\n\ts_mov_b32 m0, %0":"=&s"(keep):"v"(gsrc),"s"(lds_dst):"memory");}
__device__ __forceinline__ float max3f(float a,float b,float c){float r;asm("v_max3_f32 %0, %1, %2, %3":"=v"(r):"v"(a),"v"(b),"v"(c));return r;}
__device__ __forceinline__ float max2f(float a,float b){float r;asm("v_max_f32_e32 %0, %1, %2":"=v"(r):"v"(a),"v"(b));return r;}
__device__ __forceinline__ float fadd_s(float a,float b){float r;asm("v_add_f32_e32 %0, %1, %2":"=v"(r):"v"(a),"v"(b));return r;}
__device__ __forceinline__ float fsub_s(float a,float b){float r;asm("v_sub_f32_e32 %0, %1, %2":"=v"(r):"v"(a),"v"(b));return r;}
typedef float f32x2_t __attribute__((ext_vector_type(2))); typedef __bf16 bf16x2_t __attribute__((ext_vector_type(2)));
__device__ __forceinline__ unsigned cvtpk_s(float lo,float hi){f32x2_t v={lo,hi};bf16x2_t b=__builtin_convertvector(v,bf16x2_t);return __builtin_bit_cast(unsigned,b);}
#define WAIT_BAR(N) asm volatile("s_waitcnt vmcnt(" #N ") lgkmcnt(0)\n\ts_barrier":::"memory")

__device__ __forceinline__ void qkt(f32x16&p0,f32x16&p1,const char*Kslot,const bf16x8*qr,const f32x16&negm,int r32,int hi){
  const char*kb=Kslot+hi*1024+r32*16;
  #pragma unroll
  for(int d0=0;d0<4;++d0){
    const bf16x8 b0=*reinterpret_cast<const bf16x8*>(kb+d0*2048);
    const bf16x8 b1=*reinterpret_cast<const bf16x8*>(kb+d0*2048+512);
    if(d0==0){p0=__builtin_amdgcn_mfma_f32_32x32x16_bf16(b0,qr[0],negm,0,0,0);p1=__builtin_amdgcn_mfma_f32_32x32x16_bf16(b1,qr[0],negm,0,0,0);}
    else{p0=__builtin_amdgcn_mfma_f32_32x32x16_bf16(b0,qr[d0],p0,0,0,0);p1=__builtin_amdgcn_mfma_f32_32x32x16_bf16(b1,qr[d0],p1,0,0,0);}}
}
typedef __attribute__((address_space(3))) const char* lds_cptr;
typedef short v4i16_t __attribute__((ext_vector_type(4)));
__device__ __forceinline__ void kload8(bf16x8*kf,lds_cptr kp){
  kf[0]=*(const __attribute__((address_space(3))) bf16x8*)(kp);      kf[1]=*(const __attribute__((address_space(3))) bf16x8*)(kp+512);
  kf[2]=*(const __attribute__((address_space(3))) bf16x8*)(kp+2048); kf[3]=*(const __attribute__((address_space(3))) bf16x8*)(kp+2560);
  kf[4]=*(const __attribute__((address_space(3))) bf16x8*)(kp+4096); kf[5]=*(const __attribute__((address_space(3))) bf16x8*)(kp+4608);
  kf[6]=*(const __attribute__((address_space(3))) bf16x8*)(kp+6144); kf[7]=*(const __attribute__((address_space(3))) bf16x8*)(kp+6656);
}
__device__ __forceinline__ void kload2(bf16x8*kf,lds_cptr kp,int j){ kf[2*j]=*(const __attribute__((address_space(3))) bf16x8*)(kp+j*2048); kf[2*j+1]=*(const __attribute__((address_space(3))) bf16x8*)(kp+j*2048+512); }
__device__ __forceinline__ s16x4 vtr(lds_cptr p){ return __builtin_bit_cast(s16x4,__builtin_amdgcn_ds_read_tr16_b64_v4i16((__attribute__((address_space(3))) v4i16_t*)p)); }
__device__ __forceinline__ float rowmax(const f32x16&p0,const f32x16&p1){
  float a=max3f(p0[0],p0[1],p1[0]),b=max3f(p0[2],p0[3],p1[1]);a=max3f(a,p1[2],p1[3]);
  #pragma unroll
  for(int r=4;r<16;r+=4){a=max3f(a,p0[r],p0[r+1]);b=max3f(b,p0[r+2],p0[r+3]);a=max3f(a,p1[r],p1[r+1]);b=max3f(b,p1[r+2],p1[r+3]);}
  const float m=max2f(a,b);
  auto rr=__builtin_amdgcn_permlane32_swap(__float_as_uint(m),__float_as_uint(m),false,false);
  return max2f(__uint_as_float(rr[0]),__uint_as_float(rr[1]));
}
__device__ __forceinline__ void pv(f32x16*o,int vb,bf16x8 pa0,bf16x8 pa1,bf16x8 pa2,bf16x8 pa3){
  #pragma unroll
  for(int d0=0;d0<2;++d0){s16x4 lo[4],hi[4];
    #pragma unroll
    for(int ks=0;ks<4;++ks){
      asm volatile("ds_read_b64_tr_b16 %0,%1 offset:%c2":"=&v"(lo[ks]):"v"(vb),"i"(d0*4096+ks*1024):"memory");
      asm volatile("ds_read_b64_tr_b16 %0,%1 offset:%c2":"=&v"(hi[ks]):"v"(vb),"i"(d0*4096+ks*1024+512):"memory");}
    asm volatile("s_waitcnt lgkmcnt(0)":::"memory");SBAR();
    #define PK(k) (bf16x8){lo[k][0],lo[k][1],lo[k][2],lo[k][3],hi[k][0],hi[k][1],hi[k][2],hi[k][3]}
    o[d0]=__builtin_amdgcn_mfma_f32_32x32x16_bf16(pa0,PK(0),o[d0],0,0,0);
    o[d0]=__builtin_amdgcn_mfma_f32_32x32x16_bf16(pa1,PK(1),o[d0],0,0,0);
    o[d0]=__builtin_amdgcn_mfma_f32_32x32x16_bf16(pa2,PK(2),o[d0],0,0,0);
    o[d0]=__builtin_amdgcn_mfma_f32_32x32x16_bf16(pa3,PK(3),o[d0],0,0,0);
    #undef PK
  }
}

#ifndef ATTN_STORE16
#define ATTN_STORE16(p,v) (*(u32x4*)(p)=(v))
#endif
template<int THRL> __device__ __forceinline__ void attn_unit(int b,int qb,const bf16*Q,const bf16*__restrict__ K,const bf16*__restrict__ V,bf16*O,char*shm){
  int tid=threadIdx.x; asm volatile("":"+v"(tid)); const int lane=tid&63,r32=lane&31,hi=lane>>5; const int wid=__builtin_amdgcn_readfirstlane(tid>>6);
  const long rowbase=(long)b*SEQ; const int q0=qb*QB;
  const bf16*Qw=Q+(rowbase+q0+wid*QBLK)*QP;
  const bf16*Kh=K+rowbase*KP,*Vh=V+rowbase*KP;
  const unsigned lds0=(unsigned)(uintptr_t)shm;
  float*wsf=(float*)(shm+LDS_WS)+wid*64;
  const bf16*ksrc=Kh+(long)lane*KP+wid*8;
  const bf16*vsrc=Vh+(long)(16*(wid&3)+(lane>>2))*KP+(wid>>2)*32+(lane&3)*8;
  const unsigned kdst=lds0+LDS_K+wid*1024, vdst=lds0+LDS_V+wid*1024;
  #define DMA_K(t,slot) glds16(ksrc+(long)(t)*KVBLK*KP,(unsigned)__builtin_amdgcn_readfirstlane(kdst+(slot)))
  #define DMA_V(t,slot) glds16(vsrc+(long)(t)*KVBLK*KP,(unsigned)__builtin_amdgcn_readfirstlane(vdst+(slot)))
  const int vb0=(int)(lds0+LDS_V)+((lane>>4)&1)*32+(lane&3)*8+(4*hi+((lane&15)>>2))*64;
  const char*Kbase=shm+LDS_K; bf16x8 kf[8];
  const lds_cptr shm3=(lds_cptr)shm; const lds_cptr kp0=shm3+LDS_K+hi*1024+r32*16; const lds_cptr vp0=shm3+LDS_V+((lane>>4)&1)*32+(lane&3)*8+(4*hi+((lane&15)>>2))*64;
  const int NT=(q0+QB)/KVBLK;
  DMA_K(0,0);DMA_V(0,0);DMA_K(1,SLOTB);
  bf16x8 qr[4];
  #pragma unroll
  for(int d0=0;d0<4;++d0)qr[d0]=*reinterpret_cast<const bf16x8*>(&Qw[(long)r32*QP+d0*16+hi*8]);
  float mhat=0.f,l_reg=0.f;f32x16 o[2];o[0]=f32x16{};o[1]=f32x16{};f32x16 negm=f32x16{};asm volatile("":"+v"(negm));
  const int qrel=wid*QBLK+r32;
  #define CMASK(P0,P1,t) do{int jb_=(t)-(NT-4); if(jb_>=0)cmask(P0,P1,jb_,qrel,hi);}while(0)
  bool resc=false;
  #define START(P0,P1) do{ const float rm=rowmax(P0,P1); resc=false; \
    { const float dl=rm; mhat=fadd_s(mhat,dl); \
      _Pragma("unroll") for(int r=0;r<16;++r){P0[r]=fsub_s(P0[r],dl);P1[r]=fsub_s(P1[r],dl);} \
      _Pragma("unroll") for(int r=0;r<16;++r)negm[r]=-mhat; asm volatile("":"+v"(negm)); } \
    _Pragma("unroll") for(int r=0;r<16;++r)P0[r]=__builtin_amdgcn_exp2f(P0[r]); }while(0)
  #define RESC() do{ if(resc){ asm volatile("s_waitcnt lgkmcnt(0)":::"memory"); \
      _Pragma("unroll") for(int d_=0;d_<2;++d_) _Pragma("unroll") for(int r=0;r<16;++r)o[d_][r]*=wsf[crow(r,hi)]; } }while(0)
  f32x16 pA0,pA1,pB0,pB1;
  int sl_prev=0,sl_cur=0,sl_next=SLOTB;
  #define ROT() do{sl_prev=sl_cur;sl_cur=sl_next;sl_next=(sl_next==(NSLOT-1)*SLOTB)?0:sl_next+SLOTB;}while(0)
  DMA_K(2,2*SLOTB);
  WAIT_BAR(3);
  qkt(pA0,pA1,Kbase,qr,negm,r32,hi);asm volatile("s_nop 15\n\ts_nop 7":"+v"(pA0),"+v"(pA1));CMASK(pA0,pA1,0);
  START(pA0,pA1);
  _Pragma("unroll") for(int r=0;r<16;++r)pA1[r]=__builtin_amdgcn_exp2f(pA1[r]);
  WAIT_BAR(0);
  DMA_K(3,0);DMA_V(1,SLOTB);
  ROT();
  kload8(kf,kp0+sl_cur);
  WAIT_BAR(2);
  s16x4 vlo[8],vhi[8]; u32x4 pw0,pw1,pw2,pw3;
  #define PKW(P,B) cvtpk_s(P[B],P[B+1])
  #define PAF(k) __builtin_bit_cast(bf16x8,pw##k)
  #define VFR(i) (bf16x8){vlo[i][0],vlo[i][1],vlo[i][2],vlo[i][3],vhi[i][0],vhi[i][1],vhi[i][2],vhi[i][3]}
  #define PIN(x) asm volatile("":"+v"(x))
  #define MX3(a,b,c) __builtin_fmaxf(__builtin_fmaxf((a),(b)),(c))
  #define GAPA(MF,A0,A1,A2,A3,W0,W1,PW) do{ MF; sacc+=A0; sacc+=A1; sacc+=A2; sacc+=A3; PIN(sacc); W0; W1; PIN(PW); SBAR(); }while(0)
  #define EX(v) __builtin_amdgcn_exp2f(v)
  #define GAPB(MF,X,B) do{ MF; X[B]=EX(X[B]); X[B+1]=EX(X[B+1]); X[B+2]=EX(X[B+2]); X[B+3]=EX(X[B+3]); PIN(X); SBAR(); }while(0)
  #define VRD(i) do{ vlo[i]=vtr(vp_+(((i)>>2)*4096+((i)&3)*1024)); vhi[i]=vtr(vp_+(((i)>>2)*4096+((i)&3)*1024+512)); }while(0)
  #define KRD(G,j) do{ if(G){ kload2(kf,kp0+sl_next,j); SBAR(); } }while(0)
  #define STEP(C0,C1,P0,P1,t,GK,GV,GL) do{ SBAR(); \
    const lds_cptr vp_=vp0+sl_prev; \
    VRD(0); SBAR(); float sacc=(P0[0]+P0[1]); \
    GAPA(C0=__builtin_amdgcn_mfma_f32_32x32x16_bf16(kf[0],qr[0],negm,0,0,0), P0[2],P0[3],P0[4],P0[5],     pw0[0]=PKW(P0,0), pw0[1]=PKW(P0,2), pw0); \
    VRD(4); SBAR(); GAPA(C1=__builtin_amdgcn_mfma_f32_32x32x16_bf16(kf[1],qr[0],negm,0,0,0), P0[6],P0[7],P0[8],P0[9],     pw0[2]=PKW(P0,4), pw0[3]=PKW(P0,6), pw0); \
    VRD(1); SBAR(); GAPA(C0=__builtin_amdgcn_mfma_f32_32x32x16_bf16(kf[2],qr[1],C0,0,0,0),   P0[10],P0[11],P0[12],P0[13], pw1[0]=PKW(P0,8), pw1[1]=PKW(P0,10), pw1); \
    VRD(5); SBAR(); GAPA(C1=__builtin_amdgcn_mfma_f32_32x32x16_bf16(kf[3],qr[1],C1,0,0,0),   P0[14],P0[15],P1[0],P1[1],   pw1[2]=PKW(P0,12),pw1[3]=PKW(P0,14), pw1); \
    VRD(2); SBAR(); GAPA(C0=__builtin_amdgcn_mfma_f32_32x32x16_bf16(kf[4],qr[2],C0,0,0,0),   P1[2],P1[3],P1[4],P1[5],     pw2[0]=PKW(P1,0), pw2[1]=PKW(P1,2), pw2); \
    VRD(6); SBAR(); GAPA(C1=__builtin_amdgcn_mfma_f32_32x32x16_bf16(kf[5],qr[2],C1,0,0,0),   P1[6],P1[7],P1[8],P1[9],     pw2[2]=PKW(P1,4), pw2[3]=PKW(P1,6), pw2); \
    VRD(3); SBAR(); GAPA(C0=__builtin_amdgcn_mfma_f32_32x32x16_bf16(kf[6],qr[3],C0,0,0,0),   P1[10],P1[11],P1[12],P1[13], pw3[0]=PKW(P1,8), pw3[1]=PKW(P1,10), pw3); \
    VRD(7); SBAR(); GAPA(C1=__builtin_amdgcn_mfma_f32_32x32x16_bf16(kf[7],qr[3],C1,0,0,0),   P1[14],P1[15],0.f,0.f,       pw3[2]=PKW(P1,12),pw3[3]=PKW(P1,14), pw3); \
    l_reg+=sacc; \
    if(GK){DMA_K((t)+3,sl_cur);} if(GV){DMA_V((t)+1,sl_next);} \
    CMASK(C0,C1,t); \
    { float a=MX3(C0[0],C0[1],C1[0]),b=MX3(C0[2],C0[3],C1[1]); a=MX3(a,C1[2],C1[3]); \
      _Pragma("unroll") for(int r=4;r<16;r+=4){a=MX3(a,C0[r],C0[r+1]);b=MX3(b,C0[r+2],C0[r+3]);a=MX3(a,C1[r],C1[r+1]);b=MX3(b,C1[r+2],C1[r+3]);} \
      float rm=__builtin_fmaxf(a,b); { auto rr=__builtin_amdgcn_permlane32_swap(__float_as_uint(rm),__float_as_uint(rm),false,false); rm=__builtin_fmaxf(__uint_as_float(rr[0]),__uint_as_float(rr[1])); } \
      resc=false; \
      if(__builtin_expect(__any(rm>(float)THRL),0)){ const float dl=__builtin_fmaxf(rm,0.f); mhat+=dl; \
        _Pragma("unroll") for(int r=0;r<16;++r){C0[r]-=dl;C1[r]-=dl;} \
        _Pragma("unroll") for(int r=0;r<16;++r)negm[r]=-mhat; asm volatile("":"+v"(negm)); \
        const float f=__builtin_amdgcn_exp2f(-dl); l_reg*=f; if(hi==0)wsf[r32]=f; resc=true; } } \
    SBAR(); \
    GAPB(o[0]=__builtin_amdgcn_mfma_f32_32x32x16_bf16(PAF(0),VFR(0),o[0],0,0,0), C0,0); \
    GAPB(o[1]=__builtin_amdgcn_mfma_f32_32x32x16_bf16(PAF(0),VFR(4),o[1],0,0,0), C0,4); \
    KRD(GL,0); GAPB(o[0]=__builtin_amdgcn_mfma_f32_32x32x16_bf16(PAF(1),VFR(1),o[0],0,0,0), C0,8); \
    KRD(GL,1); GAPB(o[1]=__builtin_amdgcn_mfma_f32_32x32x16_bf16(PAF(1),VFR(5),o[1],0,0,0), C0,12); \
    KRD(GL,2); GAPB(o[0]=__builtin_amdgcn_mfma_f32_32x32x16_bf16(PAF(2),VFR(2),o[0],0,0,0), C1,0); \
    KRD(GL,3); GAPB(o[1]=__builtin_amdgcn_mfma_f32_32x32x16_bf16(PAF(2),VFR(6),o[1],0,0,0), C1,4); \
    GAPB(o[0]=__builtin_amdgcn_mfma_f32_32x32x16_bf16(PAF(3),VFR(3),o[0],0,0,0), C1,8); \
    GAPB(o[1]=__builtin_amdgcn_mfma_f32_32x32x16_bf16(PAF(3),VFR(7),o[1],0,0,0), C1,12); \
    }while(0)
  int t=1;
  #undef CMASK
  #define CMASK(P0,P1,t) do{}while(0)
  for(;t+5<NT;t+=2){
    STEP(pB0,pB1,pA0,pA1,t,true,true,true);     WAIT_BAR(2); RESC(); ROT();
    STEP(pA0,pA1,pB0,pB1,t+1,true,true,true);   WAIT_BAR(2); RESC(); ROT();
  }
  #undef CMASK
  #define CMASK(P0,P1,t) do{int jb_=(t)-(NT-4); if(jb_>=0)cmask(P0,P1,jb_,qrel,hi);}while(0)
  #define ENDW(tt) do{ if((tt)+3<NT){WAIT_BAR(2);} else if((tt)+2<NT){WAIT_BAR(1);} else {WAIT_BAR(0);} }while(0)
  for(;t+1<NT;t+=2){
    STEP(pB0,pB1,pA0,pA1,t,(t+3<NT),(t+1<NT),(t+1<NT));       ENDW(t);   RESC(); ROT();
    STEP(pA0,pA1,pB0,pB1,t+1,(t+4<NT),(t+2<NT),(t+2<NT));     ENDW(t+1); RESC(); ROT();
  }
  STEP(pB0,pB1,pA0,pA1,NT-1,false,false,false); RESC();
  { float sacc=pB0[0]+pB0[1]; _Pragma("unroll") for(int r=2;r<16;++r)sacc+=pB0[r]; _Pragma("unroll") for(int r=0;r<16;++r)sacc+=pB1[r]; l_reg+=sacc;
    pw0=(u32x4){PKW(pB0,0),PKW(pB0,2),PKW(pB0,4),PKW(pB0,6)};pw1=(u32x4){PKW(pB0,8),PKW(pB0,10),PKW(pB0,12),PKW(pB0,14)};pw2=(u32x4){PKW(pB1,0),PKW(pB1,2),PKW(pB1,4),PKW(pB1,6)};pw3=(u32x4){PKW(pB1,8),PKW(pB1,10),PKW(pB1,12),PKW(pB1,14)};
    SBAR(); pv(o,vb0+sl_cur,PAF(0),PAF(1),PAF(2),PAF(3)); }
  #undef PKW
  #undef PAF
  #undef VFR
  #undef PIN
  #undef MX3
  #undef GAPA
  #undef GAPB
  #undef EX
  #undef VRD
  #undef KRD
  #undef STEP
  #undef ENDW
  {auto rr=__builtin_amdgcn_permlane32_swap(__float_as_uint(l_reg),__float_as_uint(l_reg),false,false);l_reg=__uint_as_float(rr[0])+__uint_as_float(rr[1]);}
  if(hi==0)wsf[32+r32]=l_reg;asm volatile("s_waitcnt lgkmcnt(0)":::"memory");
  float rli[16];
  #pragma unroll
  for(int r=0;r<16;++r)rli[r]=__builtin_amdgcn_rcpf(wsf[32+crow(r,hi)]);
  bf16*Ow=O+(rowbase+q0+wid*QBLK)*OP;
  { bf16*stg=(bf16*)(shm+LDS_OST)+wid*2048;
    #pragma unroll
    for(int r=0;r<16;++r){const int orow=crow(r,hi);
      #pragma unroll
      for(int d0=0;d0<2;++d0)stg[orow*64+d0*32+r32]=__float2bfloat16(o[d0][r]*rli[r]);}
    asm volatile("s_waitcnt lgkmcnt(0)":::"memory");
    #pragma unroll
    for(int i=0;i<4;++i){const int row=i*8+(lane>>3),ch=lane&7; const u32x4 v=*(const u32x4*)(stg+row*64+ch*8); ATTN_STORE16(Ow+(long)row*OP+ch*8,v);} }
  asm volatile("s_waitcnt lgkmcnt(0)\n\ts_barrier":::"memory");
  #undef DMA_K
  #undef DMA_V
  #undef CMASK
  #undef START
  #undef RESC
  #undef ROT
}
constexpr int ATTN_LDS_BYTES=LDS_BYTES;
template<int THRL=8> __device__ __forceinline__ void attn_phase(char*lds,const bf16*Q,const bf16*KV,bf16*O,int vcu,int G){
  for(int it=vcu;it<256;it+=G){
    const int b=it>>5,vh=it&31,head=vh>>2,map=(vh>>1)&1,vhalf=vh&1;
    const bf16*Qc=Q+head*128+map*64; const bf16*Kc=KV+head*256+map*64; const bf16*Vc=KV+head*256+128+vhalf*64; bf16*Oc=O+(head*2+map)*128+vhalf*64;
    for(int i=0;i<8;++i){ const int qb=(i&1)?(i>>1):(7-(i>>1)); attn_unit<THRL>(b,qb,Qc,Kc,Vc,Oc,lds); }
  }
}
#undef SBAR
#undef WAIT_BAR
}

namespace cg = cooperative_groups;
#define GAS __attribute__((address_space(1)))
#define LAS __attribute__((address_space(3)))
typedef unsigned short bf16;
typedef unsigned v4u __attribute__((ext_vector_type(4)));
typedef unsigned v2u __attribute__((ext_vector_type(2)));
typedef float f32x4 __attribute__((ext_vector_type(4)));
constexpr int NWAVES = 8, NTHR = 512;
constexpr int M = 16384, DMOD = 1024, FF = 2816, SEQ = 2048;
constexpr float EPS = 1e-6f;
constexpr float LAMBDA_INIT = 0.35550906759096926f;
constexpr size_t MiB = 1u << 20, KiB = 1u << 10;
constexpr size_t WS_BAR = 3 * MiB, BAR_BYTES = 16 * KiB;
constexpr size_t WS_SS = 244 * MiB;
constexpr size_t WS_COS = 0, WS_SIN = 256 * KiB, WS_C8 = 512 * KiB, WS_CP = 1 * MiB, WS_CH = 2 * MiB;
constexpr size_t WS_W1IN = 4 * MiB, WS_W1OUT = 15 * MiB, WS_W2IN = 20 * MiB + 512 * KiB, WS_W2OUT = 31 * MiB + 512 * KiB;
constexpr size_t WS_RGIN = 37 * MiB, WS_GATE = 41 * MiB, WS_RGOUT = 42 * MiB, WS_WKV = 44 * MiB, WS_WQ = 48 * MiB, WS_WO = 50 * MiB;
constexpr size_t WS_XB = 52 * MiB, WS_KV = 84 * MiB, WS_ACT = 148 * MiB;
constexpr size_t WS_GB = 84 * MiB, WS_XPRE = 116 * MiB, WS_XBC = 148 * MiB, WS_BB = 180 * MiB, WS_LA = 212 * MiB;
constexpr size_t WS_Q = 148 * MiB, WS_O = 180 * MiB, WS_END = 256 * MiB;
constexpr int LDS_BYTES = 147456, MISC_OFF = 131072 + 320;

#define XB_TMO      128
#define XB_XCNT(j)  (256  + 64 * (j))
#define XB_XSUB(j)  (1280 + 64 * (j))
#define XB_XGEN(j)  (2304 + 64 * (j))
#define XB_TOP      3328
#define XB_TOPGEN   3392
#define XCD_BAR_WORDS 3456
#define XB_SPIN_CAP (1u << 18)

__device__ __forceinline__ unsigned xb_ld(unsigned* p)              { return __hip_atomic_load(p, __ATOMIC_RELAXED, __HIP_MEMORY_SCOPE_AGENT); }
__device__ __forceinline__ unsigned xb_add(unsigned* p, unsigned v) { return __hip_atomic_fetch_add(p, v, __ATOMIC_RELAXED, __HIP_MEMORY_SCOPE_AGENT); }
__device__ __forceinline__ unsigned xb_xcc_id() { return (unsigned)__builtin_amdgcn_s_getreg((3 << 11) | 20) & 0xFu; }
#define XB_SPIN(cond, bar) do { unsigned _sp = 0; while (cond) { __builtin_amdgcn_s_sleep(1); \
    if ((++_sp & 255u) == 0u) { if (xb_ld(&(bar)[XB_TMO])) break; if (_sp > XB_SPIN_CAP) { atomicAdd(&(bar)[XB_TMO], 1u); break; } } } } while (0)

struct XcdBarrier {
    unsigned* bar; unsigned x;
    volatile LAS unsigned* st;
};

__device__ __forceinline__ XcdBarrier xcd_barrier_post(unsigned* bar, volatile LAS unsigned* st) {
    XcdBarrier b; b.bar = bar; b.x = xb_xcc_id(); b.st = st;
    if (threadIdx.x == 0) (void)xb_add(&bar[XB_XCNT(b.x)], 1u);
    return b;
}
__device__ __forceinline__ void xcd_barrier_complete(unsigned* bar, unsigned x, unsigned& nloc, unsigned& nx) {
    const unsigned G = gridDim.x * gridDim.y * gridDim.z;
    unsigned sum, cnt, mine, sp = 0u;
    for (;;) {
        sum = 0u; cnt = 0u; mine = 0u;
#pragma unroll
        for (unsigned j = 0; j < 16; ++j) { const unsigned c = xb_ld(&bar[XB_XCNT(j)]); sum += c; cnt += (c > 0u) ? 1u : 0u; mine = (j == x) ? c : mine; }
        if (sum == G) break;
        __builtin_amdgcn_s_sleep(1);
        if ((++sp & 255u) == 0u) { if (xb_ld(&bar[XB_TMO])) break; if (sp > XB_SPIN_CAP) { atomicAdd(&bar[XB_TMO], 1u); break; } }
    }
    nloc = mine > 0u ? mine : 1u; nx = cnt > 0u ? cnt : 1u;
}

__device__ __forceinline__ void xcd_barrier(const XcdBarrier& b) {
    asm volatile("s_waitcnt vmcnt(0)" ::: "memory");
    __syncthreads();
    if (threadIdx.x == 0) {
        unsigned* bar = b.bar;
        __builtin_amdgcn_s_waitcnt(0);
        unsigned nloc = b.st[0], nx = b.st[1];
        if (nloc == 0u) { xcd_barrier_complete(bar, b.x, nloc, nx); b.st[0] = nloc; b.st[1] = nx; }
        const unsigned old = xb_add(&bar[XB_XSUB(b.x)], 1u);
        const unsigned gen = old / nloc;
        if (old + 1u == (gen + 1u) * nloc) {
            __builtin_amdgcn_fence(__ATOMIC_RELEASE, "agent");
            asm volatile("s_waitcnt vmcnt(0)" ::: "memory");
            const unsigned og = xb_add(&bar[XB_TOP], 1u);
            const unsigned tg = og / nx;
            if (og + 1u == (tg + 1u) * nx) xb_add(&bar[XB_TOPGEN], 1u);
            else XB_SPIN(xb_ld(&bar[XB_TOPGEN]) == tg, bar);
            __builtin_amdgcn_fence(__ATOMIC_ACQUIRE, "agent");
            xb_add(&bar[XB_XGEN(b.x)], 1u);
            asm volatile("s_waitcnt vmcnt(0)" ::: "memory");
        } else {
            XB_SPIN(xb_ld(&bar[XB_XGEN(b.x)]) == gen, bar);
            __builtin_amdgcn_fence(__ATOMIC_ACQUIRE, "agent");
            asm volatile("s_waitcnt vmcnt(0)" ::: "memory");
        }
    }
    __syncthreads();
}

__device__ __forceinline__ float wave_sum(float v) {
#pragma unroll
    for (int o = 1; o < 64; o <<= 1) v += __shfl_xor(v, o);
    return v;
}
__device__ __forceinline__ unsigned pk2(float lo, float hi) { return pg8::cvt_pk_bf16(lo, hi); }

__device__ __forceinline__ void transpose_item(const float* W, const float* gain, int K, int N, bf16* WT, int k0, int n0, int drow, LAS float* scr, int lane) {
    const float* src = W + (size_t)(k0 + (lane >> 5)) * N + n0 + (lane & 31);
    float v[32];
#pragma unroll
    for (int i = 0; i < 32; ++i) v[i] = __builtin_nontemporal_load(src + (size_t)(2 * i) * N);
    LAS float* dst = scr + (lane >> 5) * 33 + (lane & 31);
#pragma unroll
    for (int i = 0; i < 32; ++i) dst[2 * i * 33] = v[i];
    asm volatile("s_waitcnt lgkmcnt(0)" ::: "memory");
    const int c = lane & 7;
    f32x4 g0 = (f32x4){1.f, 1.f, 1.f, 1.f}, g1 = g0;
    if (gain) { g0 = *(const f32x4*)(gain + k0 + 8 * c); g1 = *(const f32x4*)(gain + k0 + 8 * c + 4); }
#pragma unroll
    for (int j = 0; j < 4; ++j) { const int n = (lane >> 3) + 8 * j; const LAS float* s = scr + (8 * c) * 33 + n;
        v4u o; o.x = pk2(s[0 * 33] * g0.x, s[1 * 33] * g0.y); o.y = pk2(s[2 * 33] * g0.z, s[3 * 33] * g0.w); o.z = pk2(s[4 * 33] * g1.x, s[5 * 33] * g1.y); o.w = pk2(s[6 * 33] * g1.z, s[7 * 33] * g1.w);
        *(v4u*)(WT + (size_t)(drow + n) * K + k0 + 8 * c) = o; }
    asm volatile("s_waitcnt lgkmcnt(0)" ::: "memory");
}
__device__ __forceinline__ int dest_row(int mode, int par, int n0) {
    if (mode == 0) return n0;
    if (mode == 1) { const int h = n0 >= par ? 1 : 0, j = h ? n0 - par : n0; return (j >> 7) * 256 + h * 128 + (j & 127); }
    if (mode == 3) { const int head = n0 >> 8, t = n0 & 255;
        if (t < 64) return head * 256 + (t >> 5) * 128 + (t & 31);
        if (t < 128) { const int d = t - 64; return head * 256 + (d >> 5) * 128 + 32 + (d & 31); }
        const int dv = t - 128; return head * 256 + (dv >> 6) * 128 + 64 + (dv & 63); }
    const int head = n0 >> 7, t = n0 & 127, map = t >> 6, d = t & 63, pn = head >> 1, grp = (head & 1) * 2 + map;
    return pn * 256 + (d >> 5) * 128 + grp * 32 + (d & 31);
}
__device__ __forceinline__ bool cvt_job(int& r, const float* W, const float* gain, int K, int N, bf16* WT, int mode, int par, LAS float* scr, int lane) {
    const int nblk = N / 32, items = (K / 64) * nblk;
    if (r >= items) { r -= items; return false; }
    const int kb = r / nblk, nb = r % nblk;
    transpose_item(W, gain, K, N, WT, 64 * kb, 32 * nb, dest_row(mode, par, 32 * nb), scr, lane);
    return true;
}
__device__ __forceinline__ void rms_row_bf16(const float* xrow, const float* gain, bf16* orow, int lane) {
    const f32x4* xr = (const f32x4*)xrow + lane; const f32x4* gr = (const f32x4*)gain + lane;
    f32x4 v[4]; float s = 0.f;
#pragma unroll
    for (int j = 0; j < 4; ++j) { v[j] = xr[64 * j]; s += (v[j].x * v[j].x + v[j].y * v[j].y) + (v[j].z * v[j].z + v[j].w * v[j].w); }
    const float r = 1.0f / sqrtf(wave_sum(s) * (1.f / 1024.f) + EPS);
    v2u* o8 = (v2u*)orow + lane;
#pragma unroll
    for (int j = 0; j < 4; ++j) { const f32x4 g = gr[64 * j]; v2u w; w.x = pk2(v[j].x * r * g.x, v[j].y * r * g.y); w.y = pk2(v[j].z * r * g.z, v[j].w * r * g.w); o8[64 * j] = w; }
}
__device__ __forceinline__ void rms_row_out(const bf16* xrow, const float* gain, float* orow, int lane) {
    float v[16]; float s = 0.f;
#pragma unroll
    for (int h = 0; h < 2; ++h) { const v4u w = *(const v4u*)(xrow + h * 512 + lane * 8);
#pragma unroll
        for (int i = 0; i < 4; ++i) { v[h * 8 + 2 * i] = pg8::bf_lo(w[i]); v[h * 8 + 2 * i + 1] = pg8::bf_hi(w[i]); } }
#pragma unroll
    for (int i = 0; i < 16; ++i) s += v[i] * v[i];
    const float r = 1.0f / sqrtf(wave_sum(s) * (1.f / 1024.f) + EPS);
#pragma unroll
    for (int h = 0; h < 2; ++h)
#pragma unroll
        for (int q = 0; q < 2; ++q) { const f32x4 g = *(const f32x4*)(gain + h * 512 + lane * 8 + 4 * q);
            *(f32x4*)(orow + h * 512 + lane * 8 + 4 * q) = (f32x4){v[h * 8 + 4 * q] * r * g.x, v[h * 8 + 4 * q + 1] * r * g.y, v[h * 8 + 4 * q + 2] * r * g.z, v[h * 8 + 4 * q + 3] * r * g.w}; }
}
__device__ __forceinline__ void raw_row2_bf16(const float* __restrict__ x0, const float* __restrict__ x1, bf16* __restrict__ o0, bf16* __restrict__ o1, float* __restrict__ s0p, float* __restrict__ s1p, int lane) {
    f32x4 a[4], b[4];
#pragma unroll
    for (int j = 0; j < 4; ++j) { a[j] = __builtin_nontemporal_load((const f32x4*)x0 + lane + 64 * j); b[j] = __builtin_nontemporal_load((const f32x4*)x1 + lane + 64 * j); }
    float sa = 0.f, sb = 0.f;
#pragma unroll
    for (int j = 0; j < 4; ++j) { sa += (a[j].x * a[j].x + a[j].y * a[j].y) + (a[j].z * a[j].z + a[j].w * a[j].w); sb += (b[j].x * b[j].x + b[j].y * b[j].y) + (b[j].z * b[j].z + b[j].w * b[j].w);
        v2u w; w.x = pk2(a[j].x, a[j].y); w.y = pk2(a[j].z, a[j].w); ((v2u*)o0)[lane + 64 * j] = w; w.x = pk2(b[j].x, b[j].y); w.y = pk2(b[j].z, b[j].w); ((v2u*)o1)[lane + 64 * j] = w; }
#pragma unroll
    for (int o = 1; o < 64; o <<= 1) { sa += __shfl_xor(sa, o); sb += __shfl_xor(sb, o); }
    if (lane < 16) { s0p[lane] = (lane == 0) ? sa : 0.f; s1p[lane] = (lane == 0) ? sb : 0.f; }
}
__device__ __forceinline__ void rms_row2_out(const bf16* __restrict__ x0, const bf16* __restrict__ x1, const float* __restrict__ gain, float* __restrict__ o0, float* __restrict__ o1, int lane) {
    v4u w[2][2];
#pragma unroll
    for (int h = 0; h < 2; ++h) { w[0][h] = *(const v4u*)(x0 + h * 512 + lane * 8); w[1][h] = *(const v4u*)(x1 + h * 512 + lane * 8); }
    float v[2][16], s[2] = {0.f, 0.f};
#pragma unroll
    for (int q = 0; q < 2; ++q)
#pragma unroll
        for (int h = 0; h < 2; ++h)
#pragma unroll
            for (int i = 0; i < 4; ++i) { const float lo = pg8::bf_lo(w[q][h][i]), hi = pg8::bf_hi(w[q][h][i]); v[q][h * 8 + 2 * i] = lo; v[q][h * 8 + 2 * i + 1] = hi; s[q] += lo * lo + hi * hi; }
#pragma unroll
    for (int o = 1; o < 64; o <<= 1) { s[0] += __shfl_xor(s[0], o); s[1] += __shfl_xor(s[1], o); }
    const float r0 = 1.0f / sqrtf(s[0] * (1.f / 1024.f) + EPS), r1 = 1.0f / sqrtf(s[1] * (1.f / 1024.f) + EPS);
#pragma unroll
    for (int h = 0; h < 2; ++h)
#pragma unroll
        for (int q4 = 0; q4 < 2; ++q4) { const f32x4 g = *(const f32x4*)(gain + h * 512 + lane * 8 + 4 * q4); const int b0 = h * 8 + 4 * q4;
            __builtin_nontemporal_store((f32x4){v[0][b0] * r0 * g.x, v[0][b0 + 1] * r0 * g.y, v[0][b0 + 2] * r0 * g.z, v[0][b0 + 3] * r0 * g.w}, (f32x4*)(o0 + h * 512 + lane * 8 + 4 * q4));
            __builtin_nontemporal_store((f32x4){v[1][b0] * r1 * g.x, v[1][b0 + 1] * r1 * g.y, v[1][b0 + 2] * r1 * g.z, v[1][b0 + 3] * r1 * g.w}, (f32x4*)(o1 + h * 512 + lane * 8 + 4 * q4)); }
}
__device__ __forceinline__ void raw_row_bf16(const float* xrow, bf16* orow, float* ssp, int lane) {
    const f32x4* xr = (const f32x4*)xrow + lane; v2u* o8 = (v2u*)orow + lane; float s = 0.f;
#pragma unroll
    for (int j = 0; j < 4; ++j) { const f32x4 v = xr[64 * j]; s += (v.x * v.x + v.y * v.y) + (v.z * v.z + v.w * v.w); v2u w; w.x = pk2(v.x, v.y); w.y = pk2(v.z, v.w); o8[64 * j] = w; }
    s = wave_sum(s); if (lane < 16) ssp[lane] = (lane == 0) ? s : 0.f;
}
__device__ __forceinline__ void rms_row_f32(const float* xrow, const float* gain, float* orow, int lane) {
    const f32x4* xr = (const f32x4*)xrow + lane; const f32x4* gr = (const f32x4*)gain + lane;
    f32x4 v[4]; float s = 0.f;
#pragma unroll
    for (int j = 0; j < 4; ++j) { v[j] = xr[64 * j]; s += (v[j].x * v[j].x + v[j].y * v[j].y) + (v[j].z * v[j].z + v[j].w * v[j].w); }
    const float r = 1.0f / sqrtf(wave_sum(s) * (1.f / 1024.f) + EPS);
    f32x4* o = (f32x4*)orow + lane;
#pragma unroll
    for (int j = 0; j < 4; ++j) { const f32x4 g = gr[64 * j]; o[64 * j] = v[j] * r * g; }
}
__device__ const double INV_FREQ[32] = {
1.00000000000000000e+00, 7.49894209332455874e-01, 5.62341325190349073e-01, 4.21696503428582226e-01,
3.16227766016837941e-01, 2.37137370566165517e-01, 1.77827941003892293e-01, 1.33352143216332403e-01,
1.00000000000000006e-01, 7.49894209332455791e-02, 5.62341325190349114e-02, 4.21696503428582239e-02,
3.16227766016837913e-02, 2.37137370566165538e-02, 1.77827941003892293e-02, 1.33352143216332406e-02,
1.00000000000000002e-02, 7.49894209332455791e-03, 5.62341325190349097e-03, 4.21696503428582292e-03,
3.16227766016837939e-03, 2.37137370566165538e-03, 1.77827941003892275e-03, 1.33352143216332406e-03,
1.00000000000000002e-03, 7.49894209332455856e-04, 5.62341325190349097e-04, 4.21696503428582237e-04,
3.16227766016837939e-04, 2.37137370566165538e-04, 1.77827941003892270e-04, 1.33352143216332395e-04};

struct Args { const float* in[24]; float* out; unsigned char* ws; };
enum { I_X = 0, I_F1N, I_F1IN, I_F1OUT, I_MIXN, I_F2N, I_F2IN, I_F2OUT, I_RGWIN, I_RGBIN, I_CONVW, I_CONVB, I_GATEW, I_GATEB, I_LAM, I_RGWOUT, I_RGBOUT,
       I_KVN, I_WKV, I_WQ, I_DLAM, I_SUBLN, I_WO, I_FINALN };

__global__ void __launch_bounds__(NTHR, 2) fwd_mega(Args args) {
    extern __shared__ __attribute__((aligned(16))) unsigned char lds_raw[];
    cg::grid_group grid = cg::this_grid();
    LAS unsigned char* lds = (LAS unsigned char*)lds_raw;
    const int G = gridDim.x, bx = blockIdx.x, vcu = (G % 8 == 0) ? (bx % 8) * (G / 8) + bx / 8 : bx;
    const int NGW = G * NWAVES, NGT = G * NTHR;
    if (args.out == nullptr) grid.sync();
    for (int u = threadIdx.x; u < (LDS_BYTES - 131072) / 4; u += NTHR) ((LAS unsigned*)(lds + 131072))[u] = 0u;
    __syncthreads();
    const XcdBarrier bar = xcd_barrier_post((unsigned*)(args.ws + WS_BAR), (volatile LAS unsigned*)(lds + MISC_OFF) + 8);
#define PHASE_IDS() PHASE_ARGS(); int tid = threadIdx.x; asm volatile("" : "+v"(tid)); const int lane = tid & 63, wave = __builtin_amdgcn_readfirstlane(tid >> 6), gw = vcu * NWAVES + wave, gt = vcu * NTHR + tid; (void)gw; (void)gt; (void)lane; LAS float* scr = (LAS float*)(lds + wave * 16384); (void)scr
    typedef const __attribute__((address_space(4))) Args* ArgsP;
#define PHASE_ARGS() ArgsP A_ = (ArgsP)__builtin_amdgcn_kernarg_segment_ptr(); asm volatile("" : "+s"(A_))
#define H (A_->out)
#define WSP(T, off) ((T*)(A_->ws + (off)))
#define SSQ(k) (WSP(float, WS_SS) + (size_t)(k) * M * 16)
#define cosT WSP(float, WS_COS)
#define sinT WSP(float, WS_SIN)
#define c8 WSP(float, WS_C8)
#define carryP WSP(float, WS_CP)
#define carryH WSP(float, WS_CH)
#define W1IN WSP(bf16, WS_W1IN)
#define W1OUT WSP(bf16, WS_W1OUT)
#define W2IN WSP(bf16, WS_W2IN)
#define W2OUT WSP(bf16, WS_W2OUT)
#define WRGIN WSP(bf16, WS_RGIN)
#define WGATE WSP(bf16, WS_GATE)
#define WRGOUT WSP(bf16, WS_RGOUT)
#define WKV WSP(bf16, WS_WKV)
#define WQ WSP(bf16, WS_WQ)
#define WO WSP(bf16, WS_WO)
#define XB WSP(bf16, WS_XB)
#define KVb WSP(bf16, WS_KV)
#define ACT WSP(bf16, WS_ACT)
#define GB WSP(bf16, WS_GB)
#define XPRE WSP(bf16, WS_XPRE)
#define LAb WSP(bf16, WS_LA)
#define XBC WSP(bf16, WS_XBC)
#define BB WSP(bf16, WS_BB)
#define Qb WSP(bf16, WS_Q)
#define Ob WSP(bf16, WS_O)

#define NORM_PHASE(src, gain) do { PHASE_IDS(); if (EN_NORM) for (int m_ = gw; m_ < M; m_ += NGW) rms_row_bf16((src) + (size_t)m_ * DMOD, (gain), XB + (size_t)m_ * DMOD, lane); } while (0)
    const int nfull = (64 * 22) % G;
    const int cvb0 = nfull ? (bx >= nfull ? bx - nfull : -1) : bx, CVB = nfull ? G - nfull : G;
#define CVJ(W, GAIN, K_, N_, WT, MODE, PAR) if (cvt_job(r, (W), (GAIN), (K_), (N_), (WT), (MODE), (PAR), scr, lane)) continue
#define CVT_SLOT(NI_, JOBS) do { PHASE_IDS(); if (cvb0 >= 0) { for (int it = cvb0 * NWAVES + wave; it < (NI_); it += CVB * NWAVES) { int r = it; JOBS; } } } while (0)
    constexpr int NI_WIN = (DMOD / 64) * (2 * FF / 32), NI_WOUT = (FF / 64) * (DMOD / 32);
#define JOBS_SLOT0 \
        CVJ(A_->in[I_F1OUT], nullptr, FF, DMOD, W1OUT, 0, 0); \
        CVJ(A_->in[I_F2IN], A_->in[I_F2N], DMOD, 2 * FF, W2IN, 1, FF); \
        CVJ(A_->in[I_RGWIN], A_->in[I_MIXN], DMOD, 2048, WRGIN, 0, 0); \
        CVJ(A_->in[I_GATEW], nullptr, 256, 512, WGATE, 1, 256); \
        CVJ(A_->in[I_GATEW] + (size_t)1 * 256 * 512, nullptr, 256, 512, WGATE + (size_t)1 * 512 * 256, 1, 256); \
        CVJ(A_->in[I_GATEW] + (size_t)2 * 256 * 512, nullptr, 256, 512, WGATE + (size_t)2 * 512 * 256, 1, 256); \
        CVJ(A_->in[I_GATEW] + (size_t)3 * 256 * 512, nullptr, 256, 512, WGATE + (size_t)3 * 512 * 256, 1, 256); \
        CVJ(A_->in[I_RGWOUT], nullptr, DMOD, DMOD, WRGOUT, 0, 0)
#define JOBS_SLOT2 \
        CVJ(A_->in[I_F1IN] + (size_t)DMOD * 2 * FF, A_->in[I_F1N] + DMOD, DMOD, 2 * FF, W1IN, 1, FF); \
        CVJ(A_->in[I_F1OUT] + (size_t)FF * DMOD, nullptr, FF, DMOD, W1OUT, 0, 0); \
        CVJ(A_->in[I_WKV], A_->in[I_KVN], DMOD, 2048, WKV, 3, 0); \
        CVJ(A_->in[I_F2OUT], nullptr, FF, DMOD, W2OUT, 0, 0)
#define JOBS_SLOT3 \
        CVJ(A_->in[I_F2IN] + (size_t)DMOD * 2 * FF, A_->in[I_F2N] + DMOD, DMOD, 2 * FF, W2IN, 1, FF); \
        CVJ(A_->in[I_F2OUT] + (size_t)FF * DMOD, nullptr, FF, DMOD, W2OUT, 0, 0); \
        CVJ(A_->in[I_WQ], A_->in[I_MIXN] + DMOD, DMOD, DMOD, WQ, 4, 0); \
        CVJ(A_->in[I_WO], nullptr, DMOD, DMOD, WO, 0, 0)
#define SLOT0() do { CVT_SLOT(NI_WOUT + NI_WIN + 1024 + 4 * 64 + 512, JOBS_SLOT0); if (PROBE == 11) CVT_SLOT(NI_WOUT + NI_WIN + 1024 + 4 * 64 + 512, JOBS_SLOT0); } while (0)
#define SLOT2() CVT_SLOT(NI_WIN + NI_WOUT + 1024 + NI_WOUT, JOBS_SLOT2)
#define SLOT3() CVT_SLOT(NI_WIN + NI_WOUT + 512 + 512, JOBS_SLOT3)
#define SLOTNONE() do { } while (0)

    { PHASE_IDS(); for (int it = gw; it < NI_WIN; it += NGW) { int r = it; CVJ(A_->in[I_F1IN], A_->in[I_F1N], DMOD, 2 * FF, W1IN, 1, FF); } }
    for (int rep8 = 0; rep8 < (PROBE == 8 ? 2 : 1); ++rep8) {
    { PHASE_IDS();
    if (EN_P0) for (int i = gt; i < SEQ * 32; i += NGT) {
        const int pos = i >> 5, d = i & 31; const double ang = (double)pos * INV_FREQ[d];
        const double q = __builtin_rint(ang * 0.63661977236758134308); const double r = __builtin_fma(-q, 1.57079632679489661923, ang), r2 = r * r;
        const double sn = r * (1.0 + r2 * (-1.0 / 6 + r2 * (1.0 / 120 + r2 * (-1.0 / 5040 + r2 * (1.0 / 362880 + r2 * (-1.0 / 39916800 + r2 * (1.0 / 6227020800.0)))))));
        const double cs = 1.0 + r2 * (-0.5 + r2 * (1.0 / 24 + r2 * (-1.0 / 720 + r2 * (1.0 / 40320 + r2 * (-1.0 / 3628800 + r2 * (1.0 / 479001600.0))))));
        const int k = ((int)q) & 3; const double s_ = (k == 0) ? sn : (k == 1) ? cs : (k == 2) ? -sn : -cs, c_ = (k == 0) ? cs : (k == 1) ? -sn : (k == 2) ? -cs : sn;
        cosT[i] = (float)c_; sinT[i] = (float)s_; }
    for (int i = gt; i < 1024; i += NGT) {
        const float l = A_->in[I_LAM][i], t = __expf(-fabsf(l));
        const float lp = (t < 0.03f) ? t * (1.0f - t * (0.5f - t * (0.33333334f - t * (0.25f - t * 0.2f)))) : __logf(1.0f + t);
        c8[i] = 8.0f * (fminf(l, 0.f) - lp); } }
    { PHASE_IDS();
      int m_ = gw;
      for (; m_ + NGW < M; m_ += 2 * NGW) raw_row2_bf16(A_->in[I_X] + (size_t)m_ * DMOD, A_->in[I_X] + (size_t)(m_ + NGW) * DMOD, XB + (size_t)m_ * DMOD, XB + (size_t)(m_ + NGW) * DMOD, SSQ(0) + (size_t)m_ * 16, SSQ(0) + (size_t)(m_ + NGW) * 16, lane);
      for (; m_ < M; m_ += NGW) raw_row_bf16(A_->in[I_X] + (size_t)m_ * DMOD, XB + (size_t)m_ * DMOD, SSQ(0) + (size_t)m_ * 16, lane); }
    }
    XBAR();

#define RTAB_OFF (131072 + 1024)
#define RTAB_FILL(S, ssp, RS) pg8::RowScale RS; { pg8::Unit u0_; RS.ss = (ssp); RS.rtab = (const LAS float*)(lds + RTAB_OFF); RS.rpm = -1; \
        if (S.next(0, u0_)) { RS.rpm = u0_.pm; int t_ = threadIdx.x; asm volatile("" : "+v"(t_)); \
            if (t_ < 256) { const f32x4* p_ = (const f32x4*)((ssp) + ((size_t)u0_.pm * 256 + t_) * 16); const f32x4 a_ = p_[0], b_ = p_[1], c_ = p_[2], d_ = p_[3]; \
                const float s_ = (((a_[0] + a_[1]) + (a_[2] + a_[3])) + ((b_[0] + b_[1]) + (b_[2] + b_[3]))) + (((c_[0] + c_[1]) + (c_[2] + c_[3])) + ((d_[0] + d_[1]) + (d_[2] + d_[3]))); \
                ((LAS float*)(lds + RTAB_OFF))[t_] = __builtin_amdgcn_rsqf(s_ * (1.0f / 1024.0f) + 1e-6f); } } \
        __syncthreads(); }

#define FFN_STEP(WIN, WOUT, ssi, SSOUT, SLOT) do { \
            { PHASE_ARGS(); pg8::Gemm g{XB, WIN, M, 2 * FF, DMOD, DMOD, DMOD, 0, 0}; pg8::StaticOrder S; S.init(M, 2 * FF, G, bx); \
              RTAB_FILL(S, SSQ(ssi), rs_); pg8::EpiSwiglu E{ACT, FF, rs_}; \
              if (PROBE == 10) { pg8::EpiCheap E2{ACT, FF}; pg8::gemm_phase<pg8::EpiCheap, pg8::StaticOrder, true, true>(lds, g, S, E2); } \
              if (EN_SWI) pg8::gemm_phase<pg8::EpiSwiglu, pg8::StaticOrder, true, true>(lds, g, S, E); \
              if (PROBE == 3) pg8::gemm_phase<pg8::EpiSwiglu, pg8::StaticOrder, true, true>(lds, g, S, E); \
              } \
            SLOT(); \
            XBAR(); \
            { PHASE_ARGS(); pg8::Gemm g{ACT, WOUT, M, DMOD, FF, FF, FF, 0, 0}; pg8::StaticOrder S; S.init(M, DMOD, G, bx); \
              pg8::EpiResid E{XB, nullptr, 0.5f, SSOUT}; \
              if (EN_RES) pg8::gemm_phase<pg8::EpiResid, pg8::StaticOrder, true, true>(lds, g, S, E); } \
            XBAR(); } while (0)

    FFN_STEP(W1IN, W1OUT, 0, SSQ(1), SLOT0);
            { PHASE_ARGS(); pg8::Gemm g{XB, WRGIN, M, 2048, DMOD, DMOD, DMOD, 0, 0}; pg8::StaticOrder S; S.init(M, 2048, G, bx);
              RTAB_FILL(S, SSQ(1), rs_); pg8::EpiRgIn E{GB, XPRE, A_->in[I_RGBIN], rs_};
              if (EN_RGIN) pg8::gemm_phase<pg8::EpiRgIn, pg8::StaticOrder, true, true>(lds, g, S, E);
              if (PROBE == 5) pg8::gemm_phase<pg8::EpiRgIn, pg8::StaticOrder, true, true>(lds, g, S, E); }
            XBAR();
            { PHASE_IDS(); pg8::GateOrder S; S.init(M, G, bx);
              { pg8::Unit t;
                for (int jb = 0; S.S.next(jb, t); ++jb) {
                    const int r0 = t.pm * 256 + (tid >> 5) * 16, c0 = t.pn * 256 + (tid & 31) * 8; const bool head = (r0 & (SEQ - 1)) == 0;
                    const f32x4 bq0 = *(const f32x4*)(A_->in[I_CONVB] + c0), bq1 = *(const f32x4*)(A_->in[I_CONVB] + c0 + 4);
                    f32x4 w[4][2];
#pragma unroll
                    for (int k = 0; k < 4; ++k) { w[k][0] = *(const f32x4*)(A_->in[I_CONVW] + k * DMOD + c0); w[k][1] = *(const f32x4*)(A_->in[I_CONVW] + k * DMOD + c0 + 4); }
                    const bf16* __restrict__ src = XPRE + (size_t)r0 * DMOD + c0; bf16* __restrict__ dst = XBC + (size_t)r0 * DMOD + c0;
                    v4u xr[19];
#pragma unroll
                    for (int jj = 0; jj < 3; ++jj) xr[jj] = head ? (v4u){0u, 0u, 0u, 0u} : *(const v4u*)(src + (ptrdiff_t)(jj - 3) * DMOD);
#pragma unroll
                    for (int jj = 0; jj < 16; ++jj) xr[3 + jj] = *(const v4u*)(src + (size_t)jj * DMOD);
#pragma unroll
                    for (int jj = 0; jj < 16; ++jj) { f32x4 a0 = bq0, a1 = bq1;
#pragma unroll
                        for (int k = 0; k < 4; ++k) { const v4u xw = xr[jj + k];
                            a0 += w[k][0] * (f32x4){pg8::bf_lo(xw.x), pg8::bf_hi(xw.x), pg8::bf_lo(xw.y), pg8::bf_hi(xw.y)};
                            a1 += w[k][1] * (f32x4){pg8::bf_lo(xw.z), pg8::bf_hi(xw.z), pg8::bf_lo(xw.w), pg8::bf_hi(xw.w)}; }
                        *(v4u*)(dst + (size_t)jj * DMOD) = pg8::pack8(a0, a1); } } }
              asm volatile("s_waitcnt vmcnt(0)" ::: "memory"); __syncthreads();
              pg8::Gemm g{XBC, WGATE, M, 2048, 256, DMOD, 256, 1, 512};
              pg8::EpiGate E{XBC, A_->in[I_GATEB], c8, LAb, BB};
              if (EN_GATE) pg8::gemm_phase<pg8::EpiGate, pg8::GateOrder, true, true>(lds, g, S, E); }
            XBAR();
            { PHASE_IDS(); LAS float* cP = (LAS float*)lds; LAS float* cH = cP + 2048;
              for (int item = vcu; item < 8 * 32; item += G) {
                const int b = item >> 5, cg = item & 31, chunk = tid >> 3, cl = (tid & 7) * 4, c4 = cg * 32 + cl; const size_t base = ((size_t)b * SEQ + chunk * 32) * DMOD + c4;
                f32x4 p = (f32x4){0.f, 0.f, 0.f, 0.f}, h = p;
#pragma unroll 16
                for (int t = 0; t < 32; ++t) { const v2u lw = *(const v2u*)(LAb + base + (size_t)t * DMOD), bw = *(const v2u*)(BB + base + (size_t)t * DMOD);
                    const f32x4 l = (f32x4){pg8::bf_lo(lw.x), pg8::bf_hi(lw.x), pg8::bf_lo(lw.y), pg8::bf_hi(lw.y)}, bb = (f32x4){pg8::bf_lo(bw.x), pg8::bf_hi(bw.x), pg8::bf_lo(bw.y), pg8::bf_hi(bw.y)};
                    const f32x4 a = (f32x4){pg8::fexp(l.x), pg8::fexp(l.y), pg8::fexp(l.z), pg8::fexp(l.w)}; h = a * h + bb; p += l; }
                *(LAS f32x4*)(cP + chunk * 32 + cl) = (f32x4){pg8::fexp(p.x), pg8::fexp(p.y), pg8::fexp(p.z), pg8::fexp(p.w)}; *(LAS f32x4*)(cH + chunk * 32 + cl) = h;
                __syncthreads();
                h = (f32x4){0.f, 0.f, 0.f, 0.f};
                for (int c = 0; c < chunk; ++c) h = *(const LAS f32x4*)(cP + c * 32 + cl) * h + *(const LAS f32x4*)(cH + c * 32 + cl);
#pragma unroll 16
                for (int t = 0; t < 32; ++t) { const v2u lw = *(const v2u*)(LAb + base + (size_t)t * DMOD), bw = *(const v2u*)(BB + base + (size_t)t * DMOD), gwd = *(const v2u*)(GB + base + (size_t)t * DMOD);
                    const f32x4 a = (f32x4){pg8::fexp(pg8::bf_lo(lw.x)), pg8::fexp(pg8::bf_hi(lw.x)), pg8::fexp(pg8::bf_lo(lw.y)), pg8::fexp(pg8::bf_hi(lw.y))};
                    h = a * h + (f32x4){pg8::bf_lo(bw.x), pg8::bf_hi(bw.x), pg8::bf_lo(bw.y), pg8::bf_hi(bw.y)};
                    v2u o; o.x = pk2(h.x * pg8::bf_lo(gwd.x), h.y * pg8::bf_hi(gwd.x)); o.y = pk2(h.z * pg8::bf_lo(gwd.y), h.w * pg8::bf_hi(gwd.y));
                    *(v2u*)(XPRE + base + (size_t)t * DMOD) = o; }
                __syncthreads(); } }
            XBAR();
            { PHASE_ARGS(); pg8::Gemm g{XPRE, WRGOUT, M, DMOD, DMOD, DMOD, DMOD, 0, 0}; pg8::StaticOrder S; S.init(M, DMOD, G, bx);
              pg8::EpiResid E{XB, A_->in[I_RGBOUT], 1.0f, SSQ(2)};
              if (EN_RES) pg8::gemm_phase<pg8::EpiResid, pg8::StaticOrder, true, true>(lds, g, S, E); }
            XBAR();
    FFN_STEP(W2IN, W2OUT, 2, SSQ(3), SLOT2);
            { PHASE_ARGS(); pg8::Gemm g{XB, WKV, M, 2048, DMOD, DMOD, DMOD, 0, 0}; pg8::StaticOrder S; S.init(M, 2048, G, bx);
              RTAB_FILL(S, SSQ(3), rs_); pg8::EpiKV E{KVb, cosT, sinT, rs_};
              if (EN_KV) pg8::gemm_phase<pg8::EpiKV, pg8::StaticOrder, true, true>(lds, g, S, E);
              if (PROBE == 5) pg8::gemm_phase<pg8::EpiKV, pg8::StaticOrder, true, true>(lds, g, S, E); }
    FFN_STEP(W1IN, W1OUT, 3, SSQ(4), SLOT3);
            { PHASE_ARGS(); pg8::Gemm g{XB, WQ, M, DMOD, DMOD, DMOD, DMOD, 0, 0}; pg8::StaticOrder S; S.init(M, DMOD, G, bx);
              RTAB_FILL(S, SSQ(4), rs_); pg8::EpiQ E{Qb, cosT, sinT, attn_body::C2, rs_};
              if (EN_Q) pg8::gemm_phase<pg8::EpiQ, pg8::StaticOrder, true, true>(lds, g, S, E);
              if (PROBE == 5) pg8::gemm_phase<pg8::EpiQ, pg8::StaticOrder, true, true>(lds, g, S, E); }
            XBAR();
            { PHASE_ARGS(); if (EN_ATT) attn_body::attn_phase<8>((char*)lds_raw, (const attn_body::bf16*)Qb, (const attn_body::bf16*)KVb, (attn_body::bf16*)Ob, vcu, G);
              if (PROBE == 2) attn_body::attn_phase<8>((char*)lds_raw, (const attn_body::bf16*)Qb, (const attn_body::bf16*)KVb, (attn_body::bf16*)Ob, vcu, G); }
            XBAR();
            if (EN_COMB) { PHASE_IDS(); const float* lp = A_->in[I_DLAM];
              const float s1 = wave_sum(lp[lane] * lp[64 + lane]), s2 = wave_sum(lp[128 + lane] * lp[192 + lane]);
              const float lam = __expf(s1) - __expf(s2) + LAMBDA_INIT;
              const int head = lane >> 3, dv0 = (lane & 7) * 16;
              float gsub[16];
#pragma unroll
              for (int i = 0; i < 16; ++i) gsub[i] = A_->in[I_SUBLN][dv0 + i] * (1.0f - LAMBDA_INIT);
              for (int rep9 = 0; rep9 < (PROBE == 9 ? 2 : 1); ++rep9) for (int m_ = gw; m_ < M; m_ += NGW) {
                  const bf16* o1p = Ob + (size_t)m_ * 2048 + head * 256 + dv0;
                  const v4u a0 = *(const v4u*)o1p, a1 = *(const v4u*)(o1p + 8), b0 = *(const v4u*)(o1p + 128), b1 = *(const v4u*)(o1p + 136);
                  float o[16];
#pragma unroll
                  for (int i = 0; i < 4; ++i) { o[2 * i] = pg8::bf_lo(a0[i]) - lam * pg8::bf_lo(b0[i]); o[2 * i + 1] = pg8::bf_hi(a0[i]) - lam * pg8::bf_hi(b0[i]);
                      o[8 + 2 * i] = pg8::bf_lo(a1[i]) - lam * pg8::bf_lo(b1[i]); o[8 + 2 * i + 1] = pg8::bf_hi(a1[i]) - lam * pg8::bf_hi(b1[i]); }
                  float ss = 0.f;
#pragma unroll
                  for (int i = 0; i < 16; ++i) ss += o[i] * o[i];
                  ss += __shfl_xor(ss, 1); ss += __shfl_xor(ss, 2); ss += __shfl_xor(ss, 4);
                  const float r = 1.0f / sqrtf(ss * (1.f / 128.f) + EPS);
                  v4u w0, w1;
#pragma unroll
                  for (int i = 0; i < 4; ++i) { w0[i] = pk2(o[2 * i] * r * gsub[2 * i], o[2 * i + 1] * r * gsub[2 * i + 1]); w1[i] = pk2(o[8 + 2 * i] * r * gsub[8 + 2 * i], o[9 + 2 * i] * r * gsub[9 + 2 * i]); }
                  bf16* op = Qb + (size_t)m_ * DMOD + head * 128 + dv0; *(v4u*)op = w0; *(v4u*)(op + 8) = w1; } }
            XBAR();
            { PHASE_ARGS(); pg8::Gemm g{Qb, WO, M, DMOD, DMOD, DMOD, DMOD, 0, 0}; pg8::StaticOrder S; S.init(M, DMOD, G, bx);
              pg8::EpiResid E{XB, nullptr, 1.0f, SSQ(5)};
              if (EN_RES) pg8::gemm_phase<pg8::EpiResid, pg8::StaticOrder, true, true>(lds, g, S, E); }
            XBAR();
    FFN_STEP(W2IN, W2OUT, 5, (float*)nullptr, SLOTNONE);
    { PHASE_IDS(); int m_ = gw;
      for (; m_ + NGW < M; m_ += 2 * NGW) rms_row2_out(XB + (size_t)m_ * DMOD, XB + (size_t)(m_ + NGW) * DMOD, A_->in[I_FINALN], H + (size_t)m_ * DMOD, H + (size_t)(m_ + NGW) * DMOD, lane);
      for (; m_ < M; m_ += NGW) rms_row_out(XB + (size_t)m_ * DMOD, A_->in[I_FINALN], H + (size_t)m_ * DMOD, lane); }
}

extern "C" void kernel_launch(void* const* d_in, const int* in_sizes, int n_in, void* d_out, int out_size, void* d_ws, size_t ws_size, hipStream_t stream) {
    static int grid = 0;
    if (grid == 0) {
        if (n_in != 24 || out_size != M * DMOD || ws_size < WS_END) { fprintf(stderr, "kernel_launch: unexpected shapes (n_in %d out %d ws %zu)\n", n_in, out_size, ws_size); grid = -1; return; }
        int dev = 0, cus = 0, per_cu = 0;
        hipGetDevice(&dev); hipDeviceGetAttribute(&cus, hipDeviceAttributeMultiprocessorCount, dev);
        if (hipFuncSetAttribute((const void*)fwd_mega, hipFuncAttributeMaxDynamicSharedMemorySize, LDS_BYTES) != hipSuccess) { fprintf(stderr, "kernel_launch: hipFuncSetAttribute failed\n"); grid = -1; return; }
        if (hipOccupancyMaxActiveBlocksPerMultiprocessor(&per_cu, (const void*)fwd_mega, NTHR, LDS_BYTES) != hipSuccess || per_cu < 1) { fprintf(stderr, "kernel_launch: occupancy query says %d\n", per_cu); per_cu = 1; }
        (void)hipGetLastError();
        grid = cus * 1;
    }
    if (grid < 0) return;
    if (hipMemsetAsync((char*)d_ws + WS_BAR, 0, BAR_BYTES, stream) != hipSuccess) { fprintf(stderr, "kernel_launch: memset failed\n"); return; }
    Args a{};
    for (int i = 0; i < 24; ++i) a.in[i] = (const float*)d_in[i];
    a.out = (float*)d_out; a.ws = (unsigned char*)d_ws;
    void* kargs[] = {&a};
    hipError_t e = hipLaunchCooperativeKernel((const void*)fwd_mega, dim3(grid), dim3(NTHR), kargs, LDS_BYTES, stream);
    if (e != hipSuccess) fprintf(stderr, "cooperative launch failed: %s (grid %d)\n", hipGetErrorString(e), grid);
}
```

```cpp
#include <hip/hip_runtime.h>
#include <hip/hip_cooperative_groups.h>
#include <hip/hip_bf16.h>
#include <cstdio>
#include <cstdint>
#include <cmath>
#ifndef EN_SWI
#define EN_SWI 1
#endif
#ifndef EN_RES
#define EN_RES 1
#endif
#ifndef EN_KV
#define EN_KV 1
#endif
#ifndef EN_RGIN
#define EN_RGIN 1
#endif
#ifndef EN_GATE
#define EN_GATE 1
#endif
#ifndef EN_Q
#define EN_Q 1
#endif
#ifndef EN_P0
#define EN_P0 1
#endif
#ifndef EN_RGM
#define EN_RGM 1
#endif
#ifndef EN_COMB
#define EN_COMB 1
#endif
#ifndef EN_NORM
#define EN_NORM 1
#endif
#ifndef PROBE
#define PROBE 0
#endif
#define XBAR() do { xcd_barrier(bar); if (PROBE == 6) xcd_barrier(bar); } while (0)
#ifndef EN_ATT
#define EN_ATT 1
#endif
namespace pg8 {
#define PG8_LAS __attribute__((address_space(3)))
typedef unsigned short bf16_t;
typedef short bf16x8 __attribute__((ext_vector_type(8)));
typedef float f32x4 __attribute__((ext_vector_type(4)));
typedef unsigned u32x4 __attribute__((ext_vector_type(4)));
constexpr int BM = 256, BK = 64, HALF = 128, HTB = HALF * BK * 2  , STAGE_BYTES = 8 * HTB, NXCD = 8, WGM = 8;

__host__ __device__ __forceinline__ int lds_byte(int r, int c) { const int st = (r >> 4) * 2 + (c >> 5), rr = r & 15, cc = c & 31, ob = rr * 64 + cc * 2; return st * 1024 + (ob ^ (((ob >> 9) & 1) << 5)); }
__host__ __device__ __forceinline__ void stage_rc(int b, int& R, int& C) { const int st = b / 1024, sb = b % 1024, swz = sb ^ (((sb >> 9) & 1) << 5); R = (st >> 1) * 16 + swz / 64; C = (st & 1) * 32 + (swz % 64) / 2; }
__host__ __device__ __forceinline__ int perm32(int rho) { const int n = rho >> 4, i = rho & 15; return 8 * (i >> 2) + 4 * n + (i & 3); }

struct Unit { int pm, pn; };
struct Gemm { const bf16_t* A; const bf16_t* Bt; int M, N, K, lda, ldb, ash, abytes; };

struct StaticOrder {
    int nM, nN, nwg, G, c;
    __host__ __device__ __forceinline__ void init(int M, int N, int G_, int c_) { nM = M / BM; nN = N / BM; nwg = nM * nN; G = G_; c = c_; }
    __host__ __device__ __forceinline__ bool next(int i, Unit& u) const {
        const long L = (long)i * G + c; if (L >= nwg) return false;
        int wgid = (int)L; { const int q = nwg / NXCD, r = nwg % NXCD, xcd = wgid % NXCD, off = wgid / NXCD; wgid = (xcd < r ? xcd * (q + 1) : r * (q + 1) + (xcd - r) * q) + off; }
        const int nig = WGM * nN, gid = wgid / nig, fm = gid * WGM, gsz = (nM - fm) < WGM ? (nM - fm) : WGM;
        u.pm = fm + ((wgid % nig) % gsz); u.pn = (wgid % nig) / gsz; return true;
    }
    __device__ __forceinline__ void a_ready(const Unit&) const {}
    __device__ __forceinline__ void done(const Unit&) const {}
};
struct GateOrder { StaticOrder S;
    __host__ __device__ __forceinline__ void init(int M, int G_, int c_) { S.init(M, 1024, G_, c_); }
    __host__ __device__ __forceinline__ bool next(int i, Unit& u) const { Unit t; if (!S.next(i >> 1, t)) return false; u.pm = t.pm; u.pn = 2 * t.pn + (i & 1); return true; }
    __device__ __forceinline__ void a_ready(const Unit&) const {}
    __device__ __forceinline__ void done(const Unit&) const {}
};


__device__ __forceinline__ unsigned cvt_pk_bf16(float lo, float hi) { unsigned r; asm volatile("v_cvt_pk_bf16_f32 %0, %1, %2" : "=v"(r) : "v"(lo), "v"(hi)); return r; }
__device__ __forceinline__ u32x4 pack8(const f32x4 a, const f32x4 b) { u32x4 w; w.x = cvt_pk_bf16(a[0], a[1]); w.y = cvt_pk_bf16(a[2], a[3]); w.z = cvt_pk_bf16(b[0], b[1]); w.w = cvt_pk_bf16(b[2], b[3]); return w; }
__device__ __forceinline__ float fexp(float x) { return __builtin_amdgcn_exp2f(x * 1.4426950408889634f); }
__device__ __forceinline__ float fsigmoid(float x) { return __builtin_amdgcn_rcpf(1.0f + fexp(-x)); }
__device__ __forceinline__ float rs_row(const float* ss, int row, int fq) { const f32x4 p = *(const f32x4*)(ss + (size_t)row * 16 + 4 * fq); float t = (p[0] + p[1]) + (p[2] + p[3]);
    t += __shfl_xor(t, 16); t += __shfl_xor(t, 32); return __builtin_amdgcn_rsqf(t * (1.0f / 1024.0f) + 1e-6f); }
struct RowScale { const float* ss; const PG8_LAS float* rtab; int rpm;
    __device__ __forceinline__ float get(int pm, int row, int fq) const { return (pm == rpm) ? rtab[row & 255] : rs_row(ss, row, fq); } };
__device__ __forceinline__ float bf_lo(unsigned w) { return __uint_as_float(w << 16); }
__device__ __forceinline__ float bf_hi(unsigned w) { return __uint_as_float(w & 0xffff0000u); }

struct EpiSwiglu {
    static constexpr bool PERM = true, AFTER_DRAIN = false;
    bf16_t* O; int ldc; RowScale rs;
    __device__ __forceinline__ void operator()(const f32x4 (&acc)[2][2][4][2], const Unit& u, int wr, int wc, int fr, int fq) const {
        const int row0 = u.pm * BM + wr * 64 + fr, col0 = u.pn * HALF + wc * 32 + 8 * fq;
#pragma unroll
        for (int ai = 0; ai < 2; ++ai)
#pragma unroll
            for (int m = 0; m < 4; ++m) {
                const int row = row0 + ai * HALF + m * 16; bf16_t* p = O + (size_t)row * ldc + col0;
                const float r = rs.get(u.pm, row, fq), c1 = -1.4426950408889634f * r, c2 = r * r;
                f32x4 v0, v1;
                { const f32x4 g0 = acc[ai][0][m][0], g1 = acc[ai][0][m][1], x0 = g0 * c1, x1 = g1 * c1; f32x4 e0, e1;
#pragma unroll
                  for (int i = 0; i < 4; ++i) { e0[i] = __builtin_amdgcn_exp2f(x0[i]); e1[i] = __builtin_amdgcn_exp2f(x1[i]); }
                  const f32x4 d0 = e0 + 1.0f, d1 = e1 + 1.0f; f32x4 q0, q1;
#pragma unroll
                  for (int i = 0; i < 4; ++i) { q0[i] = __builtin_amdgcn_rcpf(d0[i]); q1[i] = __builtin_amdgcn_rcpf(d1[i]); }
                  v0 = (g0 * acc[ai][1][m][0]) * (q0 * c2); v1 = (g1 * acc[ai][1][m][1]) * (q1 * c2); }
                *(u32x4*)p = pack8(v0, v1);
            }
    }
};
struct EpiCheap {
    static constexpr bool PERM = true, AFTER_DRAIN = false;
    bf16_t* O; int ldc;
    __device__ __forceinline__ void operator()(const f32x4 (&acc)[2][2][4][2], const Unit& u, int wr, int wc, int fr, int fq) const {
        const int row0 = u.pm * BM + wr * 64 + fr, col0 = u.pn * HALF + wc * 32 + 8 * fq;
#pragma unroll
        for (int ai = 0; ai < 2; ++ai)
#pragma unroll
            for (int m = 0; m < 4; ++m) { bf16_t* p = O + (size_t)(row0 + ai * HALF + m * 16) * ldc + col0; *(u32x4*)p = pack8(acc[ai][0][m][0] + acc[ai][1][m][0], acc[ai][0][m][1] + acc[ai][1][m][1]); }
    }
};
struct EpiResid {
    static constexpr bool PERM = true, AFTER_DRAIN = false;
    bf16_t* xb; const float* bias; float scale; float* ss;
    __device__ __forceinline__ void operator()(const f32x4 (&acc)[2][2][4][2], const Unit& u, int wr, int wc, int fr, int fq) const {
        const int row0 = u.pm * BM + wr * 64 + fr, col0 = u.pn * BM + wc * 32 + 8 * fq;
        f32x4 bv[2][2];
#pragma unroll
        for (int bj = 0; bj < 2; ++bj)
#pragma unroll
            for (int n = 0; n < 2; ++n) bv[bj][n] = bias ? *(const f32x4*)(bias + col0 + bj * HALF + 4 * n) : (f32x4){0.f, 0.f, 0.f, 0.f};
#pragma unroll
        for (int ai = 0; ai < 2; ++ai)
#pragma unroll
            for (int m = 0; m < 4; ++m) { const int row = row0 + ai * HALF + m * 16; bf16_t* p = xb + (size_t)row * 1024 + col0; float sq = 0.f;
#pragma unroll
                for (int bj = 0; bj < 2; ++bj) { const u32x4 w = *(const u32x4*)(p + bj * HALF);
                    const f32x4 o0 = (f32x4){bf_lo(w.x), bf_hi(w.x), bf_lo(w.y), bf_hi(w.y)} + (acc[ai][bj][m][0] + bv[bj][0]) * scale;
                    const f32x4 o1 = (f32x4){bf_lo(w.z), bf_hi(w.z), bf_lo(w.w), bf_hi(w.w)} + (acc[ai][bj][m][1] + bv[bj][1]) * scale;
                    sq += ((o0[0] * o0[0] + o0[1] * o0[1]) + (o0[2] * o0[2] + o0[3] * o0[3])) + ((o1[0] * o1[0] + o1[1] * o1[1]) + (o1[2] * o1[2] + o1[3] * o1[3]));
                    *(u32x4*)(p + bj * HALF) = pack8(o0, o1); }
                if (ss) { sq += __shfl_xor(sq, 16); sq += __shfl_xor(sq, 32); if (fq == 0) ss[(size_t)row * 16 + u.pn * 4 + wc] = sq; }
            }
    }
};
struct EpiRgIn {
    static constexpr bool PERM = true, AFTER_DRAIN = false;
    bf16_t* GB; bf16_t* XPRE; const float* bias; RowScale rs;
    __device__ __forceinline__ void operator()(const f32x4 (&acc)[2][2][4][2], const Unit& u, int wr, int wc, int fr, int fq) const {
        const int row0 = u.pm * BM + wr * 64 + fr, colg = u.pn * BM + wc * 32 + 8 * fq;
        const bool isg = u.pn < 4; bf16_t* dst = isg ? GB : XPRE; const int cold = isg ? colg : colg - 1024;
        f32x4 bv[2][2];
#pragma unroll
        for (int bj = 0; bj < 2; ++bj)
#pragma unroll
            for (int n = 0; n < 2; ++n) bv[bj][n] = *(const f32x4*)(bias + colg + bj * HALF + 4 * n);
#pragma unroll
        for (int ai = 0; ai < 2; ++ai)
#pragma unroll
            for (int m = 0; m < 4; ++m) { const int row = row0 + ai * HALF + m * 16; bf16_t* rowp = dst + (size_t)row * 1024 + cold; const float r = rs.get(u.pm, row, fq);
#pragma unroll
                for (int bj = 0; bj < 2; ++bj) { f32x4 v0 = acc[ai][bj][m][0] * r + bv[bj][0], v1 = acc[ai][bj][m][1] * r + bv[bj][1];
                    if (isg) {
#pragma unroll
                        for (int i = 0; i < 4; ++i) { const float a = v0[i], b = v1[i]; v0[i] = a * fsigmoid(1.5957691216057308f * (a + 0.044715f * a * a * a)); v1[i] = b * fsigmoid(1.5957691216057308f * (b + 0.044715f * b * b * b)); } }
                    *(u32x4*)(rowp + bj * HALF) = pack8(v0, v1); } }
    }
};
struct EpiGate {
    static constexpr bool PERM = true, AFTER_DRAIN = false;
    const bf16_t* XBC; const float* gate_b; const float* c8; bf16_t* LAout; bf16_t* Bout;
    __device__ __forceinline__ void operator()(const f32x4 (&acc)[2][2][4][2], const Unit& u, int wr, int wc, int fr, int fq) const {
        const int row0 = u.pm * BM + wr * 64 + fr, grp = u.pn >> 1, chl = (u.pn & 1) * HALF + wc * 32 + 8 * fq, ch0 = grp * 256 + chl;
        f32x4 bxl[2], bal[2], cc[2];
#pragma unroll
        for (int n = 0; n < 2; ++n) { bxl[n] = *(const f32x4*)(gate_b + grp * 512 + chl + 4 * n) * -1.4426950408889634f; bal[n] = *(const f32x4*)(gate_b + grp * 512 + 256 + chl + 4 * n) * -1.4426950408889634f; cc[n] = *(const f32x4*)(c8 + ch0 + 4 * n); }
#pragma unroll
        for (int ai = 0; ai < 2; ++ai)
#pragma unroll
            for (int m = 0; m < 4; ++m) { const size_t off = (size_t)(row0 + ai * HALF + m * 16) * 1024 + ch0;
                const u32x4 xw = *(const u32x4*)(XBC + off);
                f32x4 xv[2]; xv[0] = (f32x4){bf_lo(xw.x), bf_hi(xw.x), bf_lo(xw.y), bf_hi(xw.y)}; xv[1] = (f32x4){bf_lo(xw.z), bf_hi(xw.z), bf_lo(xw.w), bf_hi(xw.w)};
                f32x4 lv[2], bo[2];
#pragma unroll
                for (int n = 0; n < 2; ++n)
#pragma unroll
                    for (int i = 0; i < 4; ++i) {
                        const float gx = __builtin_amdgcn_rcpf(1.0f + __builtin_amdgcn_exp2f(__builtin_fmaf(acc[ai][0][m][n][i], -1.4426950408889634f, bxl[n][i])));
                        const float ga = __builtin_amdgcn_rcpf(1.0f + __builtin_amdgcn_exp2f(__builtin_fmaf(acc[ai][1][m][n][i], -1.4426950408889634f, bal[n][i])));
                        const float la = cc[n][i] * ga, em = __builtin_fmaxf(1.0f - __builtin_amdgcn_exp2f(la * 2.8853900817779268f), 0.0f);
                        lv[n][i] = la; bo[n][i] = __builtin_amdgcn_sqrtf(em) * (gx * xv[n][i]); }
                *(u32x4*)(LAout + off) = pack8(lv[0], lv[1]); *(u32x4*)(Bout + off) = pack8(bo[0], bo[1]);
                if (m & 1) asm volatile("" ::: "memory"); }
    }
};
struct EpiKV {
    static constexpr bool PERM = true, AFTER_DRAIN = false;
    bf16_t* KV; const float* cosT; const float* sinT; RowScale rs;
    __device__ __forceinline__ void operator()(const f32x4 (&acc)[2][2][4][2], const Unit& u, int wr, int wc, int fr, int fq) const {
        const int row0 = u.pm * BM + wr * 64 + fr;
        if (wc < 2) {
            const int ocol = u.pn * 256 + wc * 64 + 8 * fq;
#pragma unroll
            for (int ai = 0; ai < 2; ++ai)
#pragma unroll
                for (int m = 0; m < 4; ++m) { const int row = row0 + ai * HALF + m * 16, pos = row & 2047; const float r = rs.get(u.pm, row, fq);
                    f32x4 o1[2], o2[2];
#pragma unroll
                    for (int n = 0; n < 2; ++n) { const f32x4 c = *(const f32x4*)(cosT + pos * 32 + 8 * fq + 4 * n) * r, s = *(const f32x4*)(sinT + pos * 32 + 8 * fq + 4 * n) * r;
                        const f32x4 x1 = acc[ai][0][m][n], x2 = acc[ai][1][m][n]; o1[n] = x1 * c - x2 * s; o2[n] = x2 * c + x1 * s; }
                    bf16_t* p = KV + (size_t)row * 2048 + ocol; *(u32x4*)p = pack8(o1[0], o1[1]); *(u32x4*)(p + 32) = pack8(o2[0], o2[1]); }
        } else {
            const int ocol = u.pn * 256 + 128 + (wc - 2) * 32 + 8 * fq;
#pragma unroll
            for (int ai = 0; ai < 2; ++ai)
#pragma unroll
                for (int m = 0; m < 4; ++m) { const int row = row0 + ai * HALF + m * 16; bf16_t* p = KV + (size_t)row * 2048 + ocol; const float r = rs.get(u.pm, row, fq);
                    *(u32x4*)p = pack8(acc[ai][0][m][0] * r, acc[ai][0][m][1] * r); *(u32x4*)(p + 64) = pack8(acc[ai][1][m][0] * r, acc[ai][1][m][1] * r); }
        }
    }
};
struct EpiQ {
    static constexpr bool PERM = true, AFTER_DRAIN = false;
    bf16_t* Q; const float* cosT; const float* sinT; float scale; RowScale rs;
    __device__ __forceinline__ void operator()(const f32x4 (&acc)[2][2][4][2], const Unit& u, int wr, int wc, int fr, int fq) const {
        const int row0 = u.pm * BM + wr * 64 + fr, ocol = u.pn * 256 + wc * 64 + 8 * fq;
#pragma unroll
        for (int ai = 0; ai < 2; ++ai)
#pragma unroll
            for (int m = 0; m < 4; ++m) { const int row = row0 + ai * HALF + m * 16, pos = row & 2047; const float rsc = rs.get(u.pm, row, fq) * scale;
                f32x4 o1[2], o2[2];
#pragma unroll
                for (int n = 0; n < 2; ++n) { const f32x4 c = *(const f32x4*)(cosT + pos * 32 + 8 * fq + 4 * n) * rsc, s = *(const f32x4*)(sinT + pos * 32 + 8 * fq + 4 * n) * rsc;
                    const f32x4 x1 = acc[ai][0][m][n], x2 = acc[ai][1][m][n]; o1[n] = x1 * c - x2 * s; o2[n] = x2 * c + x1 * s; }
                bf16_t* p = Q + (size_t)row * 1024 + ocol; *(u32x4*)p = pack8(o1[0], o1[1]); *(u32x4*)(p + 32) = pack8(o2[0], o2[1]); }
    }
};

template <class Epi, class Sched, bool ALIGN_EPI = false, bool SP2 = false>
__device__ __forceinline__ void gemm_phase(PG8_LAS unsigned char* lds, const Gemm g, const Sched& S, const Epi& E) {
    int tid = threadIdx.x; asm volatile("" : "+v"(tid));
    const int wid = __builtin_amdgcn_readfirstlane(tid >> 6), lane = tid & 63, wr = wid >> 2, wc = wid & 3, fr = lane & 15, fq = lane >> 4;
    const int K = g.K, nt = K / BK;
    unsigned voffA[2], voffB[2];
#pragma unroll
    for (int i = 0; i < 2; ++i) { int R, C; stage_rc(tid * 16 + i * 8192, R, C); const int Rb = Epi::PERM ? ((R & ~31) + perm32(R & 31)) : R;
        voffA[i] = (unsigned)(R * g.lda + C) * 2u; voffB[i] = (unsigned)(Rb * g.ldb + C) * 2u; }
    const size_t kstep = (size_t)(BK * 2);
    const size_t hstepA = (size_t)HALF * g.lda * 2, hstepB = (size_t)HALF * g.ldb * 2;
    const size_t tstepA = 2 * hstepA, tstepB = 2 * hstepB;
    const unsigned ldsw = (unsigned)wid * 1024u;
    const int aoff = lds_byte(wr * 64 + fr, fq * 8), boff = lds_byte(wc * 32 + fr, fq * 8);
#define PG8_SA(b, h) (((b) * 2 + (h)) * HTB)
#define PG8_SB(b, h) ((4 + (b) * 2 + (h)) * HTB)
#define PG8_STAGE(bufoff, gbase, voff) do { _Pragma("unroll") for (int _i = 0; _i < 2; ++_i) \
        __builtin_amdgcn_global_load_lds((const unsigned*)((const char*)(gbase) + (voff)[_i]), (PG8_LAS unsigned*)(lds + (bufoff) + ldsw + _i * 8192), 16, 0, 0); } while (0)
#define PG8_LDA(dst, b, h) do { _Pragma("unroll") for (int m = 0; m < 4; ++m) _Pragma("unroll") for (int k = 0; k < 2; ++k) dst[m][k] = *(const PG8_LAS bf16x8*)(lds + PG8_SA(b, h) + aoff + m * 2048 + k * 1024); } while (0)
#define PG8_LDB(dst, b, h) do { _Pragma("unroll") for (int n = 0; n < 2; ++n) _Pragma("unroll") for (int k = 0; k < 2; ++k) dst[n][k] = *(const PG8_LAS bf16x8*)(lds + PG8_SB(b, h) + boff + n * 2048 + k * 1024); } while (0)
#define PG8_MMA(ai, bj, At, Bt) do { __builtin_amdgcn_s_setprio(1); _Pragma("unroll") for (int m = 0; m < 4; ++m) _Pragma("unroll") for (int n = 0; n < 2; ++n) _Pragma("unroll") for (int k = 0; k < 2; ++k) \
        acc[ai][bj][m][n] = __builtin_amdgcn_mfma_f32_16x16x32_bf16(Bt[n][k], At[m][k], acc[ai][bj][m][n], 0, 0, 0); __builtin_amdgcn_s_setprio(0); } while (0)
#define PG8_WAIT_V(n) asm volatile("s_waitcnt vmcnt(" #n ")" ::: "memory")
#define PG8_WAIT_L(n) asm volatile("s_waitcnt lgkmcnt(" #n ")" ::: "memory")
#define PG8_BAR __builtin_amdgcn_s_barrier()
#define PG8_SCHED __builtin_amdgcn_sched_barrier(0)
    Unit cur, nxt; int ui = 0;
    if (!S.next(0, cur)) return;
    f32x4 acc[2][2][4][2];
#pragma unroll
    for (int a = 0; a < 2; ++a)
#pragma unroll
        for (int b = 0; b < 2; ++b)
#pragma unroll
            for (int m = 0; m < 4; ++m)
#pragma unroll
                for (int n = 0; n < 2; ++n) acc[a][b][m][n] = (f32x4){0.f, 0.f, 0.f, 0.f};
    bf16x8 At[4][2], B0[2][2], B1[2][2];
    const char* cA = (const char*)g.A + (size_t)cur.pm * tstepA + (size_t)(cur.pn >> g.ash) * g.abytes; const char* cB = (const char*)g.Bt + (size_t)cur.pn * tstepB;
    S.a_ready(cur);
    if constexpr (SP2) {
        PG8_STAGE(PG8_SB(0, 0), cB, voffB); PG8_STAGE(PG8_SB(0, 1), cB + hstepB, voffB); PG8_STAGE(PG8_SA(0, 0), cA, voffA); PG8_STAGE(PG8_SA(0, 1), cA + hstepA, voffA);
        if (wr == 1) PG8_BAR;
        PG8_WAIT_V(2); PG8_BAR;
        PG8_STAGE(PG8_SB(1, 0), cB + kstep, voffB); PG8_STAGE(PG8_SA(1, 0), cA + kstep, voffA); PG8_STAGE(PG8_SB(1, 1), cB + hstepB + kstep, voffB);
        PG8_WAIT_V(6); PG8_BAR;
    } else {
        PG8_STAGE(PG8_SB(0, 0), cB, voffB); PG8_STAGE(PG8_SA(0, 0), cA, voffA); PG8_STAGE(PG8_SB(0, 1), cB + hstepB, voffB); PG8_STAGE(PG8_SA(0, 1), cA + hstepA, voffA);
        if (wr == 1) PG8_BAR;
        PG8_WAIT_V(4); PG8_BAR;
        PG8_STAGE(PG8_SB(1, 0), cB + kstep, voffB); PG8_STAGE(PG8_SA(1, 0), cA + kstep, voffA); PG8_STAGE(PG8_SB(1, 1), cB + hstepB + kstep, voffB);
        PG8_WAIT_V(6); PG8_BAR;
    }
    for (;;) {
        const bool has_next = S.next(ui + 1, nxt);
        const char* nA = has_next ? (const char*)g.A + (size_t)nxt.pm * tstepA + (size_t)(nxt.pn >> g.ash) * g.abytes : cA; const char* nB = has_next ? (const char*)g.Bt + (size_t)nxt.pn * tstepB : cB;
#pragma unroll 1
        for (int t = 0; t < nt; t += 2) {
            const bool last = (t == nt - 2);
            const char* a1 = cA + (size_t)(t + 1) * kstep;
            const char* a2 = last ? nA : cA + (size_t)(t + 2) * kstep; const char* b2 = last ? nB : cB + (size_t)(t + 2) * kstep;
            const char* a3 = a2 + kstep; const char* b3 = b2 + kstep;
            if (last && has_next) S.a_ready(nxt);
            if constexpr (SP2) {
            PG8_LDB(B0, 0, 0); PG8_LDB(B1, 0, 1); PG8_SCHED; PG8_LDA(At, 0, 0); PG8_STAGE(PG8_SA(1, 1), a1 + hstepA, voffA);
            PG8_WAIT_V(8); PG8_WAIT_L(0); PG8_BAR; PG8_MMA(0, 0, At, B0); PG8_MMA(0, 1, At, B1); PG8_BAR; PG8_SCHED;
            PG8_LDA(At, 0, 1); PG8_STAGE(PG8_SB(0, 0), b2, voffB); PG8_STAGE(PG8_SB(0, 1), b2 + hstepB, voffB); PG8_STAGE(PG8_SA(0, 0), a2, voffA);
            PG8_WAIT_V(8); PG8_WAIT_L(0); PG8_BAR; PG8_MMA(1, 0, At, B0); PG8_MMA(1, 1, At, B1); PG8_BAR; PG8_SCHED;
            PG8_LDB(B0, 1, 0); PG8_LDB(B1, 1, 1); PG8_SCHED; PG8_LDA(At, 1, 0); PG8_STAGE(PG8_SA(0, 1), a2 + hstepA, voffA);
            PG8_WAIT_V(8); PG8_WAIT_L(0); PG8_BAR; PG8_MMA(0, 0, At, B0); PG8_MMA(0, 1, At, B1); PG8_BAR; PG8_SCHED;
            PG8_LDA(At, 1, 1); PG8_STAGE(PG8_SB(1, 0), b3, voffB); PG8_STAGE(PG8_SB(1, 1), b3 + hstepB, voffB); PG8_STAGE(PG8_SA(1, 0), a3, voffA);
            PG8_WAIT_V(8); PG8_WAIT_L(0); PG8_BAR; PG8_MMA(1, 0, At, B0); PG8_MMA(1, 1, At, B1); PG8_BAR; PG8_SCHED;
            } else {
            PG8_LDB(B0, 0, 0); PG8_SCHED; PG8_LDA(At, 0, 0); PG8_STAGE(PG8_SA(1, 1), a1 + hstepA, voffA);
            PG8_WAIT_L(8); PG8_BAR; PG8_WAIT_L(0); PG8_MMA(0, 0, At, B0); PG8_BAR; PG8_SCHED;
            PG8_LDB(B1, 0, 1); PG8_STAGE(PG8_SB(0, 0), b2, voffB);
            PG8_BAR; PG8_WAIT_L(0); PG8_MMA(0, 1, At, B1); PG8_BAR;
            PG8_LDA(At, 0, 1); PG8_STAGE(PG8_SA(0, 0), a2, voffA);
            PG8_BAR; PG8_WAIT_L(0); PG8_MMA(1, 0, At, B0); PG8_BAR; PG8_SCHED;
            PG8_STAGE(PG8_SB(0, 1), b2 + hstepB, voffB);
            PG8_WAIT_V(6); PG8_BAR; PG8_MMA(1, 1, At, B1); PG8_BAR;
            PG8_LDB(B0, 1, 0); PG8_SCHED; PG8_LDA(At, 1, 0); PG8_STAGE(PG8_SA(0, 1), a2 + hstepA, voffA);
            PG8_WAIT_L(8); PG8_BAR; PG8_WAIT_L(0); PG8_MMA(0, 0, At, B0); PG8_BAR; PG8_SCHED;
            PG8_LDB(B1, 1, 1); PG8_STAGE(PG8_SB(1, 0), b3, voffB);
            PG8_BAR; PG8_WAIT_L(0); PG8_MMA(0, 1, At, B1); PG8_BAR;
            PG8_LDA(At, 1, 1); PG8_STAGE(PG8_SA(1, 0), a3, voffA);
            PG8_BAR; PG8_WAIT_L(0); PG8_MMA(1, 0, At, B0); PG8_BAR; PG8_SCHED;
            PG8_STAGE(PG8_SB(1, 1), b3 + hstepB, voffB);
            PG8_WAIT_V(6); PG8_BAR; PG8_MMA(1, 1, At, B1); PG8_BAR;
            }
        }
        if constexpr (ALIGN_EPI) { if (wr == 0) PG8_BAR; }
        if constexpr (!Epi::AFTER_DRAIN) { E(acc, cur, wr, wc, fr, fq); S.done(cur); }
        if (!has_next) break;
#pragma unroll
        for (int a = 0; a < 2; ++a)
#pragma unroll
            for (int b = 0; b < 2; ++b)
#pragma unroll
                for (int m = 0; m < 4; ++m)
#pragma unroll
                    for (int n = 0; n < 2; ++n) acc[a][b][m][n] = (f32x4){0.f, 0.f, 0.f, 0.f};
        cur = nxt; cA = nA; cB = nB; ++ui;
        if constexpr (ALIGN_EPI) { if (wr == 1) PG8_BAR; }
    }
    PG8_WAIT_V(0);
    if constexpr (!ALIGN_EPI) { if (wr == 0) PG8_BAR; }
    PG8_BAR;
    if constexpr (Epi::AFTER_DRAIN) { E.fused(acc, cur, wr, wc, fr, fq, lds, wid, lane); S.done(cur); }
#undef PG8_SA
#undef PG8_SB
#undef PG8_STAGE
#undef PG8_LDA
#undef PG8_LDB
#undef PG8_MMA
#undef PG8_WAIT_V
#undef PG8_WAIT_L
#undef PG8_BAR
#undef PG8_SCHED
}
}

namespace attn_body {
using bf16=__hip_bfloat16;
using bf16x8=__attribute__((ext_vector_type(8)))short;
using s16x4=__attribute__((ext_vector_type(4)))short;
using f32x16=__attribute__((ext_vector_type(16)))float;
using u32x4=__attribute__((ext_vector_type(4)))unsigned;
constexpr int SEQ=2048,D=64,QP=1024,KP=2048,OP=2048;
constexpr int NW=8,QBLK=32,QB=QBLK*NW,KVBLK=64,NQB=SEQ/QB;
constexpr int ATTN_UNIT_ROWS=QB;
__device__ __forceinline__ int crow(int r,int hi){return (r&3)+8*(r>>2)+4*hi;}
#define SBAR() __builtin_amdgcn_sched_barrier(0)
__device__ __forceinline__ void cmask(f32x16&p0,f32x16&p1,int jb,int qrel,int hi){
  const float NEG=-INFINITY; int kb=64*jb+4*hi;
  #pragma unroll
  for(int r=0;r<16;++r){int kv=kb+(r&3)+8*(r>>2); if(kv>qrel)p0[r]=NEG; if(kv+32>qrel)p1[r]=NEG;}
}

constexpr int NSLOT=3, SLOTB=8192;
constexpr int LDS_K=0, LDS_V=NSLOT*SLOTB, LDS_WS=2*NSLOT*SLOTB, LDS_OST=LDS_WS+NW*64*4, LDS_BYTES=LDS_OST+NW*4096;
constexpr float C2=0.125f*1.4426950408889634f;
__device__ __forceinline__ void glds16(const void*gsrc,unsigned lds_dst){unsigned keep;
  asm volatile("s_mov_b32 %0, m0\n\ts_mov_b32 m0, %2\n\ts_nop 0\n\tglobal_load_lds_dwordx4 %1, off\n\ts_mov_b32 m0, %0":"=&s"(keep):"v"(gsrc),"s"(lds_dst):"memory");}
__device__ __forceinline__ float max3f(float a,float b,float c){float r;asm("v_max3_f32 %0, %1, %2, %3":"=v"(r):"v"(a),"v"(b),"v"(c));return r;}
__device__ __forceinline__ float max2f(float a,float b){float r;asm("v_max_f32_e32 %0, %1, %2":"=v"(r):"v"(a),"v"(b));return r;}
__device__ __forceinline__ float fadd_s(float a,float b){float r;asm("v_add_f32_e32 %0, %1, %2":"=v"(r):"v"(a),"v"(b));return r;}
__device__ __forceinline__ float fsub_s(float a,float b){float r;asm("v_sub_f32_e32 %0, %1, %2":"=v"(r):"v"(a),"v"(b));return r;}
typedef float f32x2_t __attribute__((ext_vector_type(2))); typedef __bf16 bf16x2_t __attribute__((ext_vector_type(2)));
__device__ __forceinline__ unsigned cvtpk_s(float lo,float hi){f32x2_t v={lo,hi};bf16x2_t b=__builtin_convertvector(v,bf16x2_t);return __builtin_bit_cast(unsigned,b);}
#define WAIT_BAR(N) asm volatile("s_waitcnt vmcnt(" #N ") lgkmcnt(0)\n\ts_barrier":::"memory")

__device__ __forceinline__ void qkt(f32x16&p0,f32x16&p1,const char*Kslot,const bf16x8*qr,const f32x16&negm,int r32,int hi){
  const char*kb=Kslot+hi*1024+r32*16;
  #pragma unroll
  for(int d0=0;d0<4;++d0){
    const bf16x8 b0=*reinterpret_cast<const bf16x8*>(kb+d0*2048);
    const bf16x8 b1=*reinterpret_cast<const bf16x8*>(kb+d0*2048+512);
    if(d0==0){p0=__builtin_amdgcn_mfma_f32_32x32x16_bf16(b0,qr[0],negm,0,0,0);p1=__builtin_amdgcn_mfma_f32_32x32x16_bf16(b1,qr[0],negm,0,0,0);}
    else{p0=__builtin_amdgcn_mfma_f32_32x32x16_bf16(b0,qr[d0],p0,0,0,0);p1=__builtin_amdgcn_mfma_f32_32x32x16_bf16(b1,qr[d0],p1,0,0,0);}}
}
typedef __attribute__((address_space(3))) const char* lds_cptr;
typedef short v4i16_t __attribute__((ext_vector_type(4)));
__device__ __forceinline__ void kload8(bf16x8*kf,lds_cptr kp){
  kf[0]=*(const __attribute__((address_space(3))) bf16x8*)(kp);      kf[1]=*(const __attribute__((address_space(3))) bf16x8*)(kp+512);
  kf[2]=*(const __attribute__((address_space(3))) bf16x8*)(kp+2048); kf[3]=*(const __attribute__((address_space(3))) bf16x8*)(kp+2560);
  kf[4]=*(const __attribute__((address_space(3))) bf16x8*)(kp+4096); kf[5]=*(const __attribute__((address_space(3))) bf16x8*)(kp+4608);
  kf[6]=*(const __attribute__((address_space(3))) bf16x8*)(kp+6144); kf[7]=*(const __attribute__((address_space(3))) bf16x8*)(kp+6656);
}
__device__ __forceinline__ void kload2(bf16x8*kf,lds_cptr kp,int j){ kf[2*j]=*(const __attribute__((address_space(3))) bf16x8*)(kp+j*2048); kf[2*j+1]=*(const __attribute__((address_space(3))) bf16x8*)(kp+j*2048+512); }
__device__ __forceinline__ s16x4 vtr(lds_cptr p){ return __builtin_bit_cast(s16x4,__builtin_amdgcn_ds_read_tr16_b64_v4i16((__attribute__((address_space(3))) v4i16_t*)p)); }
__device__ __forceinline__ float rowmax(const f32x16&p0,const f32x16&p1){
  float a=max3f(p0[0],p0[1],p1[0]),b=max3f(p0[2],p0[3],p1[1]);a=max3f(a,p1[2],p1[3]);
  #pragma unroll
  for(int r=4;r<16;r+=4){a=max3f(a,p0[r],p0[r+1]);b=max3f(b,p0[r+2],p0[r+3]);a=max3f(a,p1[r],p1[r+1]);b=max3f(b,p1[r+2],p1[r+3]);}
  const float m=max2f(a,b);
  auto rr=__builtin_amdgcn_permlane32_swap(__float_as_uint(m),__float_as_uint(m),false,false);
  return max2f(__uint_as_float(rr[0]),__uint_as_float(rr[1]));
}
__device__ __forceinline__ void pv(f32x16*o,int vb,bf16x8 pa0,bf16x8 pa1,bf16x8 pa2,bf16x8 pa3){
  #pragma unroll
  for(int d0=0;d0<2;++d0){s16x4 lo[4],hi[4];
    #pragma unroll
    for(int ks=0;ks<4;++ks){
      asm volatile("ds_read_b64_tr_b16 %0,%1 offset:%c2":"=&v"(lo[ks]):"v"(vb),"i"(d0*4096+ks*1024):"memory");
      asm volatile("ds_read_b64_tr_b16 %0,%1 offset:%c2":"=&v"(hi[ks]):"v"(vb),"i"(d0*4096+ks*1024+512):"memory");}
    asm volatile("s_waitcnt lgkmcnt(0)":::"memory");SBAR();
    #define PK(k) (bf16x8){lo[k][0],lo[k][1],lo[k][2],lo[k][3],hi[k][0],hi[k][1],hi[k][2],hi[k][3]}
    o[d0]=__builtin_amdgcn_mfma_f32_32x32x16_bf16(pa0,PK(0),o[d0],0,0,0);
    o[d0]=__builtin_amdgcn_mfma_f32_32x32x16_bf16(pa1,PK(1),o[d0],0,0,0);
    o[d0]=__builtin_amdgcn_mfma_f32_32x32x16_bf16(pa2,PK(2),o[d0],0,0,0);
    o[d0]=__builtin_amdgcn_mfma_f32_32x32x16_bf16(pa3,PK(3),o[d0],0,0,0);
    #undef PK
  }
}

#ifndef ATTN_STORE16
#define ATTN_STORE16(p,v) (*(u32x4*)(p)=(v))
#endif
template<int THRL> __device__ __forceinline__ void attn_unit(int b,int qb,const bf16*Q,const bf16*__restrict__ K,const bf16*__restrict__ V,bf16*O,char*shm){
  int tid=threadIdx.x; asm volatile("":"+v"(tid)); const int lane=tid&63,r32=lane&31,hi=lane>>5; const int wid=__builtin_amdgcn_readfirstlane(tid>>6);
  const long rowbase=(long)b*SEQ; const int q0=qb*QB;
  const bf16*Qw=Q+(rowbase+q0+wid*QBLK)*QP;
  const bf16*Kh=K+rowbase*KP,*Vh=V+rowbase*KP;
  const unsigned lds0=(unsigned)(uintptr_t)shm;
  float*wsf=(float*)(shm+LDS_WS)+wid*64;
  const bf16*ksrc=Kh+(long)lane*KP+wid*8;
  const bf16*vsrc=Vh+(long)(16*(wid&3)+(lane>>2))*KP+(wid>>2)*32+(lane&3)*8;
  const unsigned kdst=lds0+LDS_K+wid*1024, vdst=lds0+LDS_V+wid*1024;
  #define DMA_K(t,slot) glds16(ksrc+(long)(t)*KVBLK*KP,(unsigned)__builtin_amdgcn_readfirstlane(kdst+(slot)))
  #define DMA_V(t,slot) glds16(vsrc+(long)(t)*KVBLK*KP,(unsigned)__builtin_amdgcn_readfirstlane(vdst+(slot)))
  const int vb0=(int)(lds0+LDS_V)+((lane>>4)&1)*32+(lane&3)*8+(4*hi+((lane&15)>>2))*64;
  const char*Kbase=shm+LDS_K; bf16x8 kf[8];
  const lds_cptr shm3=(lds_cptr)shm; const lds_cptr kp0=shm3+LDS_K+hi*1024+r32*16; const lds_cptr vp0=shm3+LDS_V+((lane>>4)&1)*32+(lane&3)*8+(4*hi+((lane&15)>>2))*64;
  const int NT=(q0+QB)/KVBLK;
  DMA_K(0,0);DMA_V(0,0);DMA_K(1,SLOTB);
  bf16x8 qr[4];
  #pragma unroll
  for(int d0=0;d0<4;++d0)qr[d0]=*reinterpret_cast<const bf16x8*>(&Qw[(long)r32*QP+d0*16+hi*8]);
  float mhat=0.f,l_reg=0.f;f32x16 o[2];o[0]=f32x16{};o[1]=f32x16{};f32x16 negm=f32x16{};asm volatile("":"+v"(negm));
  const int qrel=wid*QBLK+r32;
  #define CMASK(P0,P1,t) do{int jb_=(t)-(NT-4); if(jb_>=0)cmask(P0,P1,jb_,qrel,hi);}while(0)
  bool resc=false;
  #define START(P0,P1) do{ const float rm=rowmax(P0,P1); resc=false; \
    { const float dl=rm; mhat=fadd_s(mhat,dl); \
      _Pragma("unroll") for(int r=0;r<16;++r){P0[r]=fsub_s(P0[r],dl);P1[r]=fsub_s(P1[r],dl);} \
      _Pragma("unroll") for(int r=0;r<16;++r)negm[r]=-mhat; asm volatile("":"+v"(negm)); } \
    _Pragma("unroll") for(int r=0;r<16;++r)P0[r]=__builtin_amdgcn_exp2f(P0[r]); }while(0)
  #define RESC() do{ if(resc){ asm volatile("s_waitcnt lgkmcnt(0)":::"memory"); \
      _Pragma("unroll") for(int d_=0;d_<2;++d_) _Pragma("unroll") for(int r=0;r<16;++r)o[d_][r]*=wsf[crow(r,hi)]; } }while(0)
  f32x16 pA0,pA1,pB0,pB1;
  int sl_prev=0,sl_cur=0,sl_next=SLOTB;
  #define ROT() do{sl_prev=sl_cur;sl_cur=sl_next;sl_next=(sl_next==(NSLOT-1)*SLOTB)?0:sl_next+SLOTB;}while(0)
  DMA_K(2,2*SLOTB);
  WAIT_BAR(3);
  qkt(pA0,pA1,Kbase,qr,negm,r32,hi);asm volatile("s_nop 15\n\ts_nop 7":"+v"(pA0),"+v"(pA1));CMASK(pA0,pA1,0);
  START(pA0,pA1);
  _Pragma("unroll") for(int r=0;r<16;++r)pA1[r]=__builtin_amdgcn_exp2f(pA1[r]);
  WAIT_BAR(0);
  DMA_K(3,0);DMA_V(1,SLOTB);
  ROT();
  kload8(kf,kp0+sl_cur);
  WAIT_BAR(2);
  s16x4 vlo[8],vhi[8]; u32x4 pw0,pw1,pw2,pw3;
  #define PKW(P,B) cvtpk_s(P[B],P[B+1])
  #define PAF(k) __builtin_bit_cast(bf16x8,pw##k)
  #define VFR(i) (bf16x8){vlo[i][0],vlo[i][1],vlo[i][2],vlo[i][3],vhi[i][0],vhi[i][1],vhi[i][2],vhi[i][3]}
  #define PIN(x) asm volatile("":"+v"(x))
  #define MX3(a,b,c) __builtin_fmaxf(__builtin_fmaxf((a),(b)),(c))
  #define GAPA(MF,A0,A1,A2,A3,W0,W1,PW) do{ MF; sacc+=A0; sacc+=A1; sacc+=A2; sacc+=A3; PIN(sacc); W0; W1; PIN(PW); SBAR(); }while(0)
  #define EX(v) __builtin_amdgcn_exp2f(v)
  #define GAPB(MF,X,B) do{ MF; X[B]=EX(X[B]); X[B+1]=EX(X[B+1]); X[B+2]=EX(X[B+2]); X[B+3]=EX(X[B+3]); PIN(X); SBAR(); }while(0)
  #define VRD(i) do{ vlo[i]=vtr(vp_+(((i)>>2)*4096+((i)&3)*1024)); vhi[i]=vtr(vp_+(((i)>>2)*4096+((i)&3)*1024+512)); }while(0)
  #define KRD(G,j) do{ if(G){ kload2(kf,kp0+sl_next,j); SBAR(); } }while(0)
  #define STEP(C0,C1,P0,P1,t,GK,GV,GL) do{ SBAR(); \
    const lds_cptr vp_=vp0+sl_prev; \
    VRD(0); SBAR(); float sacc=(P0[0]+P0[1]); \
    GAPA(C0=__builtin_amdgcn_mfma_f32_32x32x16_bf16(kf[0],qr[0],negm,0,0,0), P0[2],P0[3],P0[4],P0[5],     pw0[0]=PKW(P0,0), pw0[1]=PKW(P0,2), pw0); \
    VRD(4); SBAR(); GAPA(C1=__builtin_amdgcn_mfma_f32_32x32x16_bf16(kf[1],qr[0],negm,0,0,0), P0[6],P0[7],P0[8],P0[9],     pw0[2]=PKW(P0,4), pw0[3]=PKW(P0,6), pw0); \
    VRD(1); SBAR(); GAPA(C0=__builtin_amdgcn_mfma_f32_32x32x16_bf16(kf[2],qr[1],C0,0,0,0),   P0[10],P0[11],P0[12],P0[13], pw1[0]=PKW(P0,8), pw1[1]=PKW(P0,10), pw1); \
    VRD(5); SBAR(); GAPA(C1=__builtin_amdgcn_mfma_f32_32x32x16_bf16(kf[3],qr[1],C1,0,0,0),   P0[14],P0[15],P1[0],P1[1],   pw1[2]=PKW(P0,12),pw1[3]=PKW(P0,14), pw1); \
    VRD(2); SBAR(); GAPA(C0=__builtin_amdgcn_mfma_f32_32x32x16_bf16(kf[4],qr[2],C0,0,0,0),   P1[2],P1[3],P1[4],P1[5],     pw2[0]=PKW(P1,0), pw2[1]=PKW(P1,2), pw2); \
    VRD(6); SBAR(); GAPA(C1=__builtin_amdgcn_mfma_f32_32x32x16_bf16(kf[5],qr[2],C1,0,0,0),   P1[6],P1[7],P1[8],P1[9],     pw2[2]=PKW(P1,4), pw2[3]=PKW(P1,6), pw2); \
    VRD(3); SBAR(); GAPA(C0=__builtin_amdgcn_mfma_f32_32x32x16_bf16(kf[6],qr[3],C0,0,0,0),   P1[10],P1[11],P1[12],P1[13], pw3[0]=PKW(P1,8), pw3[1]=PKW(P1,10), pw3); \
    VRD(7); SBAR(); GAPA(C1=__builtin_amdgcn_mfma_f32_32x32x16_bf16(kf[7],qr[3],C1,0,0,0),   P1[14],P1[15],0.f,0.f,       pw3[2]=PKW(P1,12),pw3[3]=PKW(P1,14), pw3); \
    l_reg+=sacc; \
    if(GK){DMA_K((t)+3,sl_cur);} if(GV){DMA_V((t)+1,sl_next);} \
    CMASK(C0,C1,t); \
    { float a=MX3(C0[0],C0[1],C1[0]),b=MX3(C0[2],C0[3],C1[1]); a=MX3(a,C1[2],C1[3]); \
      _Pragma("unroll") for(int r=4;r<16;r+=4){a=MX3(a,C0[r],C0[r+1]);b=MX3(b,C0[r+2],C0[r+3]);a=MX3(a,C1[r],C1[r+1]);b=MX3(b,C1[r+2],C1[r+3]);} \
      float rm=__builtin_fmaxf(a,b); { auto rr=__builtin_amdgcn_permlane32_swap(__float_as_uint(rm),__float_as_uint(rm),false,false); rm=__builtin_fmaxf(__uint_as_float(rr[0]),__uint_as_float(rr[1])); } \
      resc=false; \
      if(__builtin_expect(__any(rm>(float)THRL),0)){ const float dl=__builtin_fmaxf(rm,0.f); mhat+=dl; \
        _Pragma("unroll") for(int r=0;r<16;++r){C0[r]-=dl;C1[r]-=dl;} \
        _Pragma("unroll") for(int r=0;r<16;++r)negm[r]=-mhat; asm volatile("":"+v"(negm)); \
        const float f=__builtin_amdgcn_exp2f(-dl); l_reg*=f; if(hi==0)wsf[r32]=f; resc=true; } } \
    SBAR(); \
    GAPB(o[0]=__builtin_amdgcn_mfma_f32_32x32x16_bf16(PAF(0),VFR(0),o[0],0,0,0), C0,0); \
    GAPB(o[1]=__builtin_amdgcn_mfma_f32_32x32x16_bf16(PAF(0),VFR(4),o[1],0,0,0), C0,4); \
    KRD(GL,0); GAPB(o[0]=__builtin_amdgcn_mfma_f32_32x32x16_bf16(PAF(1),VFR(1),o[0],0,0,0), C0,8); \
    KRD(GL,1); GAPB(o[1]=__builtin_amdgcn_mfma_f32_32x32x16_bf16(PAF(1),VFR(5),o[1],0,0,0), C0,12); \
    KRD(GL,2); GAPB(o[0]=__builtin_amdgcn_mfma_f32_32x32x16_bf16(PAF(2),VFR(2),o[0],0,0,0), C1,0); \
    KRD(GL,3); GAPB(o[1]=__builtin_amdgcn_mfma_f32_32x32x16_bf16(PAF(2),VFR(6),o[1],0,0,0), C1,4); \
    GAPB(o[0]=__builtin_amdgcn_mfma_f32_32x32x16_bf16(PAF(3),VFR(3),o[0],0,0,0), C1,8); \
    GAPB(o[1]=__builtin_amdgcn_mfma_f32_32x32x16_bf16(PAF(3),VFR(7),o[1],0,0,0), C1,12); \
    }while(0)
  int t=1;
  #undef CMASK
  #define CMASK(P0,P1,t) do{}while(0)
  for(;t+5<NT;t+=2){
    STEP(pB0,pB1,pA0,pA1,t,true,true,true);     WAIT_BAR(2); RESC(); ROT();
    STEP(pA0,pA1,pB0,pB1,t+1,true,true,true);   WAIT_BAR(2); RESC(); ROT();
  }
  #undef CMASK
  #define CMASK(P0,P1,t) do{int jb_=(t)-(NT-4); if(jb_>=0)cmask(P0,P1,jb_,qrel,hi);}while(0)
  #define ENDW(tt) do{ if((tt)+3<NT){WAIT_BAR(2);} else if((tt)+2<NT){WAIT_BAR(1);} else {WAIT_BAR(0);} }while(0)
  for(;t+1<NT;t+=2){
    STEP(pB0,pB1,pA0,pA1,t,(t+3<NT),(t+1<NT),(t+1<NT));       ENDW(t);   RESC(); ROT();
    STEP(pA0,pA1,pB0,pB1,t+1,(t+4<NT),(t+2<NT),(t+2<NT));     ENDW(t+1); RESC(); ROT();
  }
  STEP(pB0,pB1,pA0,pA1,NT-1,false,false,false); RESC();
  { float sacc=pB0[0]+pB0[1]; _Pragma("unroll") for(int r=2;r<16;++r)sacc+=pB0[r]; _Pragma("unroll") for(int r=0;r<16;++r)sacc+=pB1[r]; l_reg+=sacc;
    pw0=(u32x4){PKW(pB0,0),PKW(pB0,2),PKW(pB0,4),PKW(pB0,6)};pw1=(u32x4){PKW(pB0,8),PKW(pB0,10),PKW(pB0,12),PKW(pB0,14)};pw2=(u32x4){PKW(pB1,0),PKW(pB1,2),PKW(pB1,4),PKW(pB1,6)};pw3=(u32x4){PKW(pB1,8),PKW(pB1,10),PKW(pB1,12),PKW(pB1,14)};
    SBAR(); pv(o,vb0+sl_cur,PAF(0),PAF(1),PAF(2),PAF(3)); }
  #undef PKW
  #undef PAF
  #undef VFR
  #undef PIN
  #undef MX3
  #undef GAPA
  #undef GAPB
  #undef EX
  #undef VRD
  #undef KRD
  #undef STEP
  #undef ENDW
  {auto rr=__builtin_amdgcn_permlane32_swap(__float_as_uint(l_reg),__float_as_uint(l_reg),false,false);l_reg=__uint_as_float(rr[0])+__uint_as_float(rr[1]);}
  if(hi==0)wsf[32+r32]=l_reg;asm volatile("s_waitcnt lgkmcnt(0)":::"memory");
  float rli[16];
  #pragma unroll
  for(int r=0;r<16;++r)rli[r]=__builtin_amdgcn_rcpf(wsf[32+crow(r,hi)]);
  bf16*Ow=O+(rowbase+q0+wid*QBLK)*OP;
  { bf16*stg=(bf16*)(shm+LDS_OST)+wid*2048;
    #pragma unroll
    for(int r=0;r<16;++r){const int orow=crow(r,hi);
      #pragma unroll
      for(int d0=0;d0<2;++d0)stg[orow*64+d0*32+r32]=__float2bfloat16(o[d0][r]*rli[r]);}
    asm volatile("s_waitcnt lgkmcnt(0)":::"memory");
    #pragma unroll
    for(int i=0;i<4;++i){const int row=i*8+(lane>>3),ch=lane&7; const u32x4 v=*(const u32x4*)(stg+row*64+ch*8); ATTN_STORE16(Ow+(long)row*OP+ch*8,v);} }
  asm volatile("s_waitcnt lgkmcnt(0)\n\ts_barrier":::"memory");
  #undef DMA_K
  #undef DMA_V
  #undef CMASK
  #undef START
  #undef RESC
  #undef ROT
}
constexpr int ATTN_LDS_BYTES=LDS_BYTES;
template<int THRL=8> __device__ __forceinline__ void attn_phase(char*lds,const bf16*Q,const bf16*KV,bf16*O,int vcu,int G){
  for(int it=vcu;it<256;it+=G){
    const int b=it>>5,j=it&31,map=(j>>1)&1,vhalf=j&1,q0=j>>2;
    #pragma unroll 1
    for(int s=0;s<8;++s){ const int head=s,qb=(q0+s)&7;
      attn_unit<THRL>(b,qb,Q+head*128+map*64,KV+head*256+map*64,KV+head*256+128+vhalf*64,O+(head*2+map)*128+vhalf*64,lds); }
  }
}
#undef SBAR
#undef WAIT_BAR
}

namespace cg = cooperative_groups;
#define GAS __attribute__((address_space(1)))
#define LAS __attribute__((address_space(3)))
typedef unsigned short bf16;
typedef unsigned v4u __attribute__((ext_vector_type(4)));
typedef unsigned v2u __attribute__((ext_vector_type(2)));
typedef float f32x4 __attribute__((ext_vector_type(4)));
constexpr int NWAVES = 8, NTHR = 512;
constexpr int M = 16384, DMOD = 1024, FF = 2816, SEQ = 2048;
constexpr float EPS = 1e-6f;
constexpr float LAMBDA_INIT = 0.35550906759096926f;
constexpr size_t MiB = 1u << 20, KiB = 1u << 10;
constexpr size_t WS_BAR = 3 * MiB, BAR_BYTES = 16 * KiB;
constexpr size_t WS_SS = 244 * MiB;
constexpr size_t WS_COS = 0, WS_SIN = 256 * KiB, WS_C8 = 512 * KiB, WS_CP = 1 * MiB, WS_CH = 2 * MiB;
constexpr size_t WS_W1IN = 4 * MiB, WS_W1OUT = 15 * MiB, WS_W2IN = 20 * MiB + 512 * KiB, WS_W2OUT = 31 * MiB + 512 * KiB;
constexpr size_t WS_RGIN = 37 * MiB, WS_GATE = 41 * MiB, WS_RGOUT = 42 * MiB, WS_WKV = 44 * MiB, WS_WQ = 48 * MiB, WS_WO = 50 * MiB;
constexpr size_t WS_XB = 52 * MiB, WS_KV = 84 * MiB, WS_ACT = 148 * MiB;
constexpr size_t WS_GB = 84 * MiB, WS_XPRE = 116 * MiB, WS_XBC = 148 * MiB, WS_BB = 180 * MiB, WS_LA = 212 * MiB;
constexpr size_t WS_Q = 148 * MiB, WS_O = 180 * MiB, WS_END = 256 * MiB;
constexpr int LDS_BYTES = 147456, MISC_OFF = 131072 + 320;

#define XB_TMO      128
#define XB_XCNT(j)  (256  + 64 * (j))
#define XB_XSUB(j)  (1280 + 64 * (j))
#define XB_XGEN(j)  (2304 + 64 * (j))
#define XB_TOP      3328
#define XB_TOPGEN   3392
#define XCD_BAR_WORDS 3456
#define XB_SPIN_CAP (1u << 18)

__device__ __forceinline__ unsigned xb_ld(unsigned* p)              { return __hip_atomic_load(p, __ATOMIC_RELAXED, __HIP_MEMORY_SCOPE_AGENT); }
__device__ __forceinline__ unsigned xb_add(unsigned* p, unsigned v) { return __hip_atomic_fetch_add(p, v, __ATOMIC_RELAXED, __HIP_MEMORY_SCOPE_AGENT); }
__device__ __forceinline__ unsigned xb_xcc_id() { return (unsigned)__builtin_amdgcn_s_getreg((3 << 11) | 20) & 0xFu; }
#define XB_SPIN(cond, bar) do { unsigned _sp = 0; while (cond) { __builtin_amdgcn_s_sleep(1); \
    if ((++_sp & 255u) == 0u) { if (xb_ld(&(bar)[XB_TMO])) break; if (_sp > XB_SPIN_CAP) { atomicAdd(&(bar)[XB_TMO], 1u); break; } } } } while (0)

struct XcdBarrier {
    unsigned* bar; unsigned x;
    volatile LAS unsigned* st;
};

__device__ __forceinline__ XcdBarrier xcd_barrier_post(unsigned* bar, volatile LAS unsigned* st) {
    XcdBarrier b; b.bar = bar; b.x = xb_xcc_id(); b.st = st;
    if (threadIdx.x == 0) (void)xb_add(&bar[XB_XCNT(b.x)], 1u);
    return b;
}
__device__ __forceinline__ void xcd_barrier_complete(unsigned* bar, unsigned x, unsigned& nloc, unsigned& nx) {
    const unsigned G = gridDim.x * gridDim.y * gridDim.z;
    unsigned sum, cnt, mine, sp = 0u;
    for (;;) {
        sum = 0u; cnt = 0u; mine = 0u;
#pragma unroll
        for (unsigned j = 0; j < 16; ++j) { const unsigned c = xb_ld(&bar[XB_XCNT(j)]); sum += c; cnt += (c > 0u) ? 1u : 0u; mine = (j == x) ? c : mine; }
        if (sum == G) break;
        __builtin_amdgcn_s_sleep(1);
        if ((++sp & 255u) == 0u) { if (xb_ld(&bar[XB_TMO])) break; if (sp > XB_SPIN_CAP) { atomicAdd(&bar[XB_TMO], 1u); break; } }
    }
    nloc = mine > 0u ? mine : 1u; nx = cnt > 0u ? cnt : 1u;
}

__device__ __forceinline__ void xcd_barrier(const XcdBarrier& b) {
    asm volatile("s_waitcnt vmcnt(0)" ::: "memory");
    __syncthreads();
    if (threadIdx.x == 0) {
        unsigned* bar = b.bar;
        __builtin_amdgcn_s_waitcnt(0);
        unsigned nloc = b.st[0], nx = b.st[1];
        if (nloc == 0u) { xcd_barrier_complete(bar, b.x, nloc, nx); b.st[0] = nloc; b.st[1] = nx; }
        const unsigned old = xb_add(&bar[XB_XSUB(b.x)], 1u);
        const unsigned gen = old / nloc;
        if (old + 1u == (gen + 1u) * nloc) {
            __builtin_amdgcn_fence(__ATOMIC_RELEASE, "agent");
            asm volatile("s_waitcnt vmcnt(0)" ::: "memory");
            const unsigned og = xb_add(&bar[XB_TOP], 1u);
            const unsigned tg = og / nx;
            if (og + 1u == (tg + 1u) * nx) xb_add(&bar[XB_TOPGEN], 1u);
            else XB_SPIN(xb_ld(&bar[XB_TOPGEN]) == tg, bar);
            __builtin_amdgcn_fence(__ATOMIC_ACQUIRE, "agent");
            xb_add(&bar[XB_XGEN(b.x)], 1u);
            asm volatile("s_waitcnt vmcnt(0)" ::: "memory");
        } else {
            XB_SPIN(xb_ld(&bar[XB_XGEN(b.x)]) == gen, bar);
            __builtin_amdgcn_fence(__ATOMIC_ACQUIRE, "agent");
            asm volatile("s_waitcnt vmcnt(0)" ::: "memory");
        }
    }
    __syncthreads();
}

__device__ __forceinline__ float wave_sum(float v) {
#pragma unroll
    for (int o = 1; o < 64; o <<= 1) v += __shfl_xor(v, o);
    return v;
}
__device__ __forceinline__ unsigned pk2(float lo, float hi) { return pg8::cvt_pk_bf16(lo, hi); }

__device__ __forceinline__ void transpose_item(const float* W, const float* gain, int K, int N, bf16* WT, int k0, int n0, int drow, LAS float* scr, int lane) {
    const float* src = W + (size_t)(k0 + (lane >> 5)) * N + n0 + (lane & 31);
    float v[32];
#pragma unroll
    for (int i = 0; i < 32; ++i) v[i] = __builtin_nontemporal_load(src + (size_t)(2 * i) * N);
    LAS float* dst = scr + (lane >> 5) * 33 + (lane & 31);
#pragma unroll
    for (int i = 0; i < 32; ++i) dst[2 * i * 33] = v[i];
    asm volatile("s_waitcnt lgkmcnt(0)" ::: "memory");
    const int c = lane & 7;
    f32x4 g0 = (f32x4){1.f, 1.f, 1.f, 1.f}, g1 = g0;
    if (gain) { g0 = *(const f32x4*)(gain + k0 + 8 * c); g1 = *(const f32x4*)(gain + k0 + 8 * c + 4); }
#pragma unroll
    for (int j = 0; j < 4; ++j) { const int n = (lane >> 3) + 8 * j; const LAS float* s = scr + (8 * c) * 33 + n;
        v4u o; o.x = pk2(s[0 * 33] * g0.x, s[1 * 33] * g0.y); o.y = pk2(s[2 * 33] * g0.z, s[3 * 33] * g0.w); o.z = pk2(s[4 * 33] * g1.x, s[5 * 33] * g1.y); o.w = pk2(s[6 * 33] * g1.z, s[7 * 33] * g1.w);
        *(v4u*)(WT + (size_t)(drow + n) * K + k0 + 8 * c) = o; }
    asm volatile("s_waitcnt lgkmcnt(0)" ::: "memory");
}
__device__ __forceinline__ int dest_row(int mode, int par, int n0) {
    if (mode == 0) return n0;
    if (mode == 1) { const int h = n0 >= par ? 1 : 0, j = h ? n0 - par : n0; return (j >> 7) * 256 + h * 128 + (j & 127); }
    if (mode == 3) { const int head = n0 >> 8, t = n0 & 255;
        if (t < 64) return head * 256 + (t >> 5) * 128 + (t & 31);
        if (t < 128) { const int d = t - 64; return head * 256 + (d >> 5) * 128 + 32 + (d & 31); }
        const int dv = t - 128; return head * 256 + (dv >> 6) * 128 + 64 + (dv & 63); }
    const int head = n0 >> 7, t = n0 & 127, map = t >> 6, d = t & 63, pn = head >> 1, grp = (head & 1) * 2 + map;
    return pn * 256 + (d >> 5) * 128 + grp * 32 + (d & 31);
}
__device__ __forceinline__ bool cvt_job(int& r, const float* W, const float* gain, int K, int N, bf16* WT, int mode, int par, LAS float* scr, int lane) {
    const int nblk = N / 32, items = (K / 64) * nblk;
    if (r >= items) { r -= items; return false; }
    const int kb = r / nblk, nb = r % nblk;
    transpose_item(W, gain, K, N, WT, 64 * kb, 32 * nb, dest_row(mode, par, 32 * nb), scr, lane);
    return true;
}
__device__ __forceinline__ void rms_row_bf16(const float* xrow, const float* gain, bf16* orow, int lane) {
    const f32x4* xr = (const f32x4*)xrow + lane; const f32x4* gr = (const f32x4*)gain + lane;
    f32x4 v[4]; float s = 0.f;
#pragma unroll
    for (int j = 0; j < 4; ++j) { v[j] = xr[64 * j]; s += (v[j].x * v[j].x + v[j].y * v[j].y) + (v[j].z * v[j].z + v[j].w * v[j].w); }
    const float r = 1.0f / sqrtf(wave_sum(s) * (1.f / 1024.f) + EPS);
    v2u* o8 = (v2u*)orow + lane;
#pragma unroll
    for (int j = 0; j < 4; ++j) { const f32x4 g = gr[64 * j]; v2u w; w.x = pk2(v[j].x * r * g.x, v[j].y * r * g.y); w.y = pk2(v[j].z * r * g.z, v[j].w * r * g.w); o8[64 * j] = w; }
}
__device__ __forceinline__ void rms_row_out(const bf16* xrow, const float* gain, float* orow, int lane) {
    float v[16]; float s = 0.f;
#pragma unroll
    for (int h = 0; h < 2; ++h) { const v4u w = *(const v4u*)(xrow + h * 512 + lane * 8);
#pragma unroll
        for (int i = 0; i < 4; ++i) { v[h * 8 + 2 * i] = pg8::bf_lo(w[i]); v[h * 8 + 2 * i + 1] = pg8::bf_hi(w[i]); } }
#pragma unroll
    for (int i = 0; i < 16; ++i) s += v[i] * v[i];
    const float r = 1.0f / sqrtf(wave_sum(s) * (1.f / 1024.f) + EPS);
#pragma unroll
    for (int h = 0; h < 2; ++h)
#pragma unroll
        for (int q = 0; q < 2; ++q) { const f32x4 g = *(const f32x4*)(gain + h * 512 + lane * 8 + 4 * q);
            *(f32x4*)(orow + h * 512 + lane * 8 + 4 * q) = (f32x4){v[h * 8 + 4 * q] * r * g.x, v[h * 8 + 4 * q + 1] * r * g.y, v[h * 8 + 4 * q + 2] * r * g.z, v[h * 8 + 4 * q + 3] * r * g.w}; }
}
__device__ __forceinline__ void raw_row2_bf16(const float* __restrict__ x0, const float* __restrict__ x1, bf16* __restrict__ o0, bf16* __restrict__ o1, float* __restrict__ s0p, float* __restrict__ s1p, int lane) {
    f32x4 a[4], b[4];
#pragma unroll
    for (int j = 0; j < 4; ++j) { a[j] = __builtin_nontemporal_load((const f32x4*)x0 + lane + 64 * j); b[j] = __builtin_nontemporal_load((const f32x4*)x1 + lane + 64 * j); }
    float sa = 0.f, sb = 0.f;
#pragma unroll
    for (int j = 0; j < 4; ++j) { sa += (a[j].x * a[j].x + a[j].y * a[j].y) + (a[j].z * a[j].z + a[j].w * a[j].w); sb += (b[j].x * b[j].x + b[j].y * b[j].y) + (b[j].z * b[j].z + b[j].w * b[j].w);
        v2u w; w.x = pk2(a[j].x, a[j].y); w.y = pk2(a[j].z, a[j].w); ((v2u*)o0)[lane + 64 * j] = w; w.x = pk2(b[j].x, b[j].y); w.y = pk2(b[j].z, b[j].w); ((v2u*)o1)[lane + 64 * j] = w; }
#pragma unroll
    for (int o = 1; o < 64; o <<= 1) { sa += __shfl_xor(sa, o); sb += __shfl_xor(sb, o); }
    if (lane < 16) { s0p[lane] = (lane == 0) ? sa : 0.f; s1p[lane] = (lane == 0) ? sb : 0.f; }
}
__device__ __forceinline__ void rms_row2_out(const bf16* __restrict__ x0, const bf16* __restrict__ x1, const float* __restrict__ gain, float* __restrict__ o0, float* __restrict__ o1, int lane) {
    v4u w[2][2];
#pragma unroll
    for (int h = 0; h < 2; ++h) { w[0][h] = *(const v4u*)(x0 + h * 512 + lane * 8); w[1][h] = *(const v4u*)(x1 + h * 512 + lane * 8); }
    float v[2][16], s[2] = {0.f, 0.f};
#pragma unroll
    for (int q = 0; q < 2; ++q)
#pragma unroll
        for (int h = 0; h < 2; ++h)
#pragma unroll
            for (int i = 0; i < 4; ++i) { const float lo = pg8::bf_lo(w[q][h][i]), hi = pg8::bf_hi(w[q][h][i]); v[q][h * 8 + 2 * i] = lo; v[q][h * 8 + 2 * i + 1] = hi; s[q] += lo * lo + hi * hi; }
#pragma unroll
    for (int o = 1; o < 64; o <<= 1) { s[0] += __shfl_xor(s[0], o); s[1] += __shfl_xor(s[1], o); }
    const float r0 = 1.0f / sqrtf(s[0] * (1.f / 1024.f) + EPS), r1 = 1.0f / sqrtf(s[1] * (1.f / 1024.f) + EPS);
#pragma unroll
    for (int h = 0; h < 2; ++h)
#pragma unroll
        for (int q4 = 0; q4 < 2; ++q4) { const f32x4 g = *(const f32x4*)(gain + h * 512 + lane * 8 + 4 * q4); const int b0 = h * 8 + 4 * q4;
            __builtin_nontemporal_store((f32x4){v[0][b0] * r0 * g.x, v[0][b0 + 1] * r0 * g.y, v[0][b0 + 2] * r0 * g.z, v[0][b0 + 3] * r0 * g.w}, (f32x4*)(o0 + h * 512 + lane * 8 + 4 * q4));
            __builtin_nontemporal_store((f32x4){v[1][b0] * r1 * g.x, v[1][b0 + 1] * r1 * g.y, v[1][b0 + 2] * r1 * g.z, v[1][b0 + 3] * r1 * g.w}, (f32x4*)(o1 + h * 512 + lane * 8 + 4 * q4)); }
}
__device__ __forceinline__ void raw_row_bf16(const float* xrow, bf16* orow, float* ssp, int lane) {
    const f32x4* xr = (const f32x4*)xrow + lane; v2u* o8 = (v2u*)orow + lane; float s = 0.f;
#pragma unroll
    for (int j = 0; j < 4; ++j) { const f32x4 v = xr[64 * j]; s += (v.x * v.x + v.y * v.y) + (v.z * v.z + v.w * v.w); v2u w; w.x = pk2(v.x, v.y); w.y = pk2(v.z, v.w); o8[64 * j] = w; }
    s = wave_sum(s); if (lane < 16) ssp[lane] = (lane == 0) ? s : 0.f;
}
__device__ __forceinline__ void rms_row_f32(const float* xrow, const float* gain, float* orow, int lane) {
    const f32x4* xr = (const f32x4*)xrow + lane; const f32x4* gr = (const f32x4*)gain + lane;
    f32x4 v[4]; float s = 0.f;
#pragma unroll
    for (int j = 0; j < 4; ++j) { v[j] = xr[64 * j]; s += (v[j].x * v[j].x + v[j].y * v[j].y) + (v[j].z * v[j].z + v[j].w * v[j].w); }
    const float r = 1.0f / sqrtf(wave_sum(s) * (1.f / 1024.f) + EPS);
    f32x4* o = (f32x4*)orow + lane;
#pragma unroll
    for (int j = 0; j < 4; ++j) { const f32x4 g = gr[64 * j]; o[64 * j] = v[j] * r * g; }
}
__device__ const double INV_FREQ[32] = {
1.00000000000000000e+00, 7.49894209332455874e-01, 5.62341325190349073e-01, 4.21696503428582226e-01,
3.16227766016837941e-01, 2.37137370566165517e-01, 1.77827941003892293e-01, 1.33352143216332403e-01,
1.00000000000000006e-01, 7.49894209332455791e-02, 5.62341325190349114e-02, 4.21696503428582239e-02,
3.16227766016837913e-02, 2.37137370566165538e-02, 1.77827941003892293e-02, 1.33352143216332406e-02,
1.00000000000000002e-02, 7.49894209332455791e-03, 5.62341325190349097e-03, 4.21696503428582292e-03,
3.16227766016837939e-03, 2.37137370566165538e-03, 1.77827941003892275e-03, 1.33352143216332406e-03,
1.00000000000000002e-03, 7.49894209332455856e-04, 5.62341325190349097e-04, 4.21696503428582237e-04,
3.16227766016837939e-04, 2.37137370566165538e-04, 1.77827941003892270e-04, 1.33352143216332395e-04};

struct Args { const float* in[24]; float* out; unsigned char* ws; };
enum { I_X = 0, I_F1N, I_F1IN, I_F1OUT, I_MIXN, I_F2N, I_F2IN, I_F2OUT, I_RGWIN, I_RGBIN, I_CONVW, I_CONVB, I_GATEW, I_GATEB, I_LAM, I_RGWOUT, I_RGBOUT,
       I_KVN, I_WKV, I_WQ, I_DLAM, I_SUBLN, I_WO, I_FINALN };

__global__ void __launch_bounds__(NTHR, 2) fwd_mega(Args args) {
    extern __shared__ __attribute__((aligned(16))) unsigned char lds_raw[];
    cg::grid_group grid = cg::this_grid();
    LAS unsigned char* lds = (LAS unsigned char*)lds_raw;
    const int G = gridDim.x, bx = blockIdx.x, vcu = (G % 8 == 0) ? (bx % 8) * (G / 8) + bx / 8 : bx;
    const int NGW = G * NWAVES, NGT = G * NTHR;
    if (args.out == nullptr) grid.sync();
    for (int u = threadIdx.x; u < (LDS_BYTES - 131072) / 4; u += NTHR) ((LAS unsigned*)(lds + 131072))[u] = 0u;
    __syncthreads();
    const XcdBarrier bar = xcd_barrier_post((unsigned*)(args.ws + WS_BAR), (volatile LAS unsigned*)(lds + MISC_OFF) + 8);
#define PHASE_IDS() PHASE_ARGS(); int tid = threadIdx.x; asm volatile("" : "+v"(tid)); const int lane = tid & 63, wave = __builtin_amdgcn_readfirstlane(tid >> 6), gw = vcu * NWAVES + wave, gt = vcu * NTHR + tid; (void)gw; (void)gt; (void)lane; LAS float* scr = (LAS float*)(lds + wave * 16384); (void)scr
    typedef const __attribute__((address_space(4))) Args* ArgsP;
#define PHASE_ARGS() ArgsP A_ = (ArgsP)__builtin_amdgcn_kernarg_segment_ptr(); asm volatile("" : "+s"(A_))
#define H (A_->out)
#define WSP(T, off) ((T*)(A_->ws + (off)))
#define SSQ(k) (WSP(float, WS_SS) + (size_t)(k) * M * 16)
#define cosT WSP(float, WS_COS)
#define sinT WSP(float, WS_SIN)
#define c8 WSP(float, WS_C8)
#define carryP WSP(float, WS_CP)
#define carryH WSP(float, WS_CH)
#define W1IN WSP(bf16, WS_W1IN)
#define W1OUT WSP(bf16, WS_W1OUT)
#define W2IN WSP(bf16, WS_W2IN)
#define W2OUT WSP(bf16, WS_W2OUT)
#define WRGIN WSP(bf16, WS_RGIN)
#define WGATE WSP(bf16, WS_GATE)
#define WRGOUT WSP(bf16, WS_RGOUT)
#define WKV WSP(bf16, WS_WKV)
#define WQ WSP(bf16, WS_WQ)
#define WO WSP(bf16, WS_WO)
#define XB WSP(bf16, WS_XB)
#define KVb WSP(bf16, WS_KV)
#define ACT WSP(bf16, WS_ACT)
#define GB WSP(bf16, WS_GB)
#define XPRE WSP(bf16, WS_XPRE)
#define LAb WSP(bf16, WS_LA)
#define XBC WSP(bf16, WS_XBC)
#define BB WSP(bf16, WS_BB)
#define Qb WSP(bf16, WS_Q)
#define Ob WSP(bf16, WS_O)

#define NORM_PHASE(src, gain) do { PHASE_IDS(); if (EN_NORM) for (int m_ = gw; m_ < M; m_ += NGW) rms_row_bf16((src) + (size_t)m_ * DMOD, (gain), XB + (size_t)m_ * DMOD, lane); } while (0)
    const int nfull = (64 * 22) % G;
    const int cvb0 = nfull ? (bx >= nfull ? bx - nfull : -1) : bx, CVB = nfull ? G - nfull : G;
#define CVJ(W, GAIN, K_, N_, WT, MODE, PAR) if (cvt_job(r, (W), (GAIN), (K_), (N_), (WT), (MODE), (PAR), scr, lane)) continue
#define CVT_SLOT(NI_, JOBS) do { PHASE_IDS(); if (cvb0 >= 0) { for (int it = cvb0 * NWAVES + wave; it < (NI_); it += CVB * NWAVES) { int r = it; JOBS; } } } while (0)
    constexpr int NI_WIN = (DMOD / 64) * (2 * FF / 32), NI_WOUT = (FF / 64) * (DMOD / 32);
#define JOBS_SLOT0 \
        CVJ(A_->in[I_F1OUT], nullptr, FF, DMOD, W1OUT, 0, 0); \
        CVJ(A_->in[I_F2IN], A_->in[I_F2N], DMOD, 2 * FF, W2IN, 1, FF); \
        CVJ(A_->in[I_RGWIN], A_->in[I_MIXN], DMOD, 2048, WRGIN, 0, 0); \
        CVJ(A_->in[I_GATEW], nullptr, 256, 512, WGATE, 1, 256); \
        CVJ(A_->in[I_GATEW] + (size_t)1 * 256 * 512, nullptr, 256, 512, WGATE + (size_t)1 * 512 * 256, 1, 256); \
        CVJ(A_->in[I_GATEW] + (size_t)2 * 256 * 512, nullptr, 256, 512, WGATE + (size_t)2 * 512 * 256, 1, 256); \
        CVJ(A_->in[I_GATEW] + (size_t)3 * 256 * 512, nullptr, 256, 512, WGATE + (size_t)3 * 512 * 256, 1, 256); \
        CVJ(A_->in[I_RGWOUT], nullptr, DMOD, DMOD, WRGOUT, 0, 0)
#define JOBS_SLOT2 \
        CVJ(A_->in[I_F1IN] + (size_t)DMOD * 2 * FF, A_->in[I_F1N] + DMOD, DMOD, 2 * FF, W1IN, 1, FF); \
        CVJ(A_->in[I_F1OUT] + (size_t)FF * DMOD, nullptr, FF, DMOD, W1OUT, 0, 0); \
        CVJ(A_->in[I_WKV], A_->in[I_KVN], DMOD, 2048, WKV, 3, 0); \
        CVJ(A_->in[I_F2OUT], nullptr, FF, DMOD, W2OUT, 0, 0)
#define JOBS_SLOT3 \
        CVJ(A_->in[I_F2IN] + (size_t)DMOD * 2 * FF, A_->in[I_F2N] + DMOD, DMOD, 2 * FF, W2IN, 1, FF); \
        CVJ(A_->in[I_F2OUT] + (size_t)FF * DMOD, nullptr, FF, DMOD, W2OUT, 0, 0); \
        CVJ(A_->in[I_WQ], A_->in[I_MIXN] + DMOD, DMOD, DMOD, WQ, 4, 0); \
        CVJ(A_->in[I_WO], nullptr, DMOD, DMOD, WO, 0, 0)
#define SLOT0() do { CVT_SLOT(NI_WOUT + NI_WIN + 1024 + 4 * 64 + 512, JOBS_SLOT0); if (PROBE == 11) CVT_SLOT(NI_WOUT + NI_WIN + 1024 + 4 * 64 + 512, JOBS_SLOT0); } while (0)
#define SLOT2() CVT_SLOT(NI_WIN + NI_WOUT + 1024 + NI_WOUT, JOBS_SLOT2)
#define SLOT3() CVT_SLOT(NI_WIN + NI_WOUT + 512 + 512, JOBS_SLOT3)
#define SLOTNONE() do { } while (0)

    { PHASE_IDS(); for (int it = gw; it < NI_WIN; it += NGW) { int r = it; CVJ(A_->in[I_F1IN], A_->in[I_F1N], DMOD, 2 * FF, W1IN, 1, FF); } }
    for (int rep8 = 0; rep8 < (PROBE == 8 ? 2 : 1); ++rep8) {
    { PHASE_IDS();
    if (EN_P0) for (int i = gt; i < SEQ * 32; i += NGT) {
        const int pos = i >> 5, d = i & 31; const double ang = (double)pos * INV_FREQ[d];
        const double q = __builtin_rint(ang * 0.63661977236758134308); const double r = __builtin_fma(-q, 1.57079632679489661923, ang), r2 = r * r;
        const double sn = r * (1.0 + r2 * (-1.0 / 6 + r2 * (1.0 / 120 + r2 * (-1.0 / 5040 + r2 * (1.0 / 362880 + r2 * (-1.0 / 39916800 + r2 * (1.0 / 6227020800.0)))))));
        const double cs = 1.0 + r2 * (-0.5 + r2 * (1.0 / 24 + r2 * (-1.0 / 720 + r2 * (1.0 / 40320 + r2 * (-1.0 / 3628800 + r2 * (1.0 / 479001600.0))))));
        const int k = ((int)q) & 3; const double s_ = (k == 0) ? sn : (k == 1) ? cs : (k == 2) ? -sn : -cs, c_ = (k == 0) ? cs : (k == 1) ? -sn : (k == 2) ? -cs : sn;
        cosT[i] = (float)c_; sinT[i] = (float)s_; }
    for (int i = gt; i < 1024; i += NGT) {
        const float l = A_->in[I_LAM][i], t = __expf(-fabsf(l));
        const float lp = (t < 0.03f) ? t * (1.0f - t * (0.5f - t * (0.33333334f - t * (0.25f - t * 0.2f)))) : __logf(1.0f + t);
        c8[i] = 8.0f * (fminf(l, 0.f) - lp); } }
    { PHASE_IDS();
      int m_ = gw;
      for (; m_ + NGW < M; m_ += 2 * NGW) raw_row2_bf16(A_->in[I_X] + (size_t)m_ * DMOD, A_->in[I_X] + (size_t)(m_ + NGW) * DMOD, XB + (size_t)m_ * DMOD, XB + (size_t)(m_ + NGW) * DMOD, SSQ(0) + (size_t)m_ * 16, SSQ(0) + (size_t)(m_ + NGW) * 16, lane);
      for (; m_ < M; m_ += NGW) raw_row_bf16(A_->in[I_X] + (size_t)m_ * DMOD, XB + (size_t)m_ * DMOD, SSQ(0) + (size_t)m_ * 16, lane); }
    }
    XBAR();

#define RTAB_OFF (131072 + 1024)
#define RTAB_FILL(S, ssp, RS) pg8::RowScale RS; { pg8::Unit u0_; RS.ss = (ssp); RS.rtab = (const LAS float*)(lds + RTAB_OFF); RS.rpm = -1; \
        if (S.next(0, u0_)) { RS.rpm = u0_.pm; int t_ = threadIdx.x; asm volatile("" : "+v"(t_)); \
            if (t_ < 256) { const f32x4* p_ = (const f32x4*)((ssp) + ((size_t)u0_.pm * 256 + t_) * 16); const f32x4 a_ = p_[0], b_ = p_[1], c_ = p_[2], d_ = p_[3]; \
                const float s_ = (((a_[0] + a_[1]) + (a_[2] + a_[3])) + ((b_[0] + b_[1]) + (b_[2] + b_[3]))) + (((c_[0] + c_[1]) + (c_[2] + c_[3])) + ((d_[0] + d_[1]) + (d_[2] + d_[3]))); \
                ((LAS float*)(lds + RTAB_OFF))[t_] = __builtin_amdgcn_rsqf(s_ * (1.0f / 1024.0f) + 1e-6f); } } \
        __syncthreads(); }

#define FFN_STEP(WIN, WOUT, ssi, SSOUT, SLOT) do { \
            { PHASE_ARGS(); pg8::Gemm g{XB, WIN, M, 2 * FF, DMOD, DMOD, DMOD, 0, 0}; pg8::StaticOrder S; S.init(M, 2 * FF, G, bx); \
              RTAB_FILL(S, SSQ(ssi), rs_); pg8::EpiSwiglu E{ACT, FF, rs_}; \
              if (PROBE == 10) { pg8::EpiCheap E2{ACT, FF}; pg8::gemm_phase<pg8::EpiCheap, pg8::StaticOrder, true, true>(lds, g, S, E2); } \
              if (EN_SWI) pg8::gemm_phase<pg8::EpiSwiglu, pg8::StaticOrder, true, true>(lds, g, S, E); \
              if (PROBE == 3) pg8::gemm_phase<pg8::EpiSwiglu, pg8::StaticOrder, true, true>(lds, g, S, E); \
              } \
            SLOT(); \
            XBAR(); \
            { PHASE_ARGS(); pg8::Gemm g{ACT, WOUT, M, DMOD, FF, FF, FF, 0, 0}; pg8::StaticOrder S; S.init(M, DMOD, G, bx); \
              pg8::EpiResid E{XB, nullptr, 0.5f, SSOUT}; \
              if (EN_RES) pg8::gemm_phase<pg8::EpiResid, pg8::StaticOrder, true, true>(lds, g, S, E); } \
            XBAR(); } while (0)

    FFN_STEP(W1IN, W1OUT, 0, SSQ(1), SLOT0);
            { PHASE_ARGS(); pg8::Gemm g{XB, WRGIN, M, 2048, DMOD, DMOD, DMOD, 0, 0}; pg8::StaticOrder S; S.init(M, 2048, G, bx);
              RTAB_FILL(S, SSQ(1), rs_); pg8::EpiRgIn E{GB, XPRE, A_->in[I_RGBIN], rs_};
              if (EN_RGIN) pg8::gemm_phase<pg8::EpiRgIn, pg8::StaticOrder, true, true>(lds, g, S, E);
              if (PROBE == 5) pg8::gemm_phase<pg8::EpiRgIn, pg8::StaticOrder, true, true>(lds, g, S, E); }
            XBAR();
            { PHASE_IDS(); pg8::GateOrder S; S.init(M, G, bx);
              { pg8::Unit t;
                for (int jb = 0; S.S.next(jb, t); ++jb) {
                    const int r0 = t.pm * 256 + (tid >> 5) * 16, c0 = t.pn * 256 + (tid & 31) * 8; const bool head = (r0 & (SEQ - 1)) == 0;
                    const f32x4 bq0 = *(const f32x4*)(A_->in[I_CONVB] + c0), bq1 = *(const f32x4*)(A_->in[I_CONVB] + c0 + 4);
                    f32x4 w[4][2];
#pragma unroll
                    for (int k = 0; k < 4; ++k) { w[k][0] = *(const f32x4*)(A_->in[I_CONVW] + k * DMOD + c0); w[k][1] = *(const f32x4*)(A_->in[I_CONVW] + k * DMOD + c0 + 4); }
                    const bf16* __restrict__ src = XPRE + (size_t)r0 * DMOD + c0; bf16* __restrict__ dst = XBC + (size_t)r0 * DMOD + c0;
                    v4u xr[19];
#pragma unroll
                    for (int jj = 0; jj < 3; ++jj) xr[jj] = head ? (v4u){0u, 0u, 0u, 0u} : *(const v4u*)(src + (ptrdiff_t)(jj - 3) * DMOD);
#pragma unroll
                    for (int jj = 0; jj < 16; ++jj) xr[3 + jj] = *(const v4u*)(src + (size_t)jj * DMOD);
#pragma unroll
                    for (int jj = 0; jj < 16; ++jj) { f32x4 a0 = bq0, a1 = bq1;
#pragma unroll
                        for (int k = 0; k < 4; ++k) { const v4u xw = xr[jj + k];
                            a0 += w[k][0] * (f32x4){pg8::bf_lo(xw.x), pg8::bf_hi(xw.x), pg8::bf_lo(xw.y), pg8::bf_hi(xw.y)};
                            a1 += w[k][1] * (f32x4){pg8::bf_lo(xw.z), pg8::bf_hi(xw.z), pg8::bf_lo(xw.w), pg8::bf_hi(xw.w)}; }
                        *(v4u*)(dst + (size_t)jj * DMOD) = pg8::pack8(a0, a1); } } }
              asm volatile("s_waitcnt vmcnt(0)" ::: "memory"); __syncthreads();
              pg8::Gemm g{XBC, WGATE, M, 2048, 256, DMOD, 256, 1, 512};
              pg8::EpiGate E{XBC, A_->in[I_GATEB], c8, LAb, BB};
              if (EN_GATE) pg8::gemm_phase<pg8::EpiGate, pg8::GateOrder, true, true>(lds, g, S, E); }
            XBAR();
            { PHASE_IDS(); LAS float* cP = (LAS float*)lds; LAS float* cH = cP + 2048;
              for (int item = vcu; item < 8 * 32; item += G) {
                const int b = item >> 5, cg = item & 31, chunk = tid >> 3, cl = (tid & 7) * 4, c4 = cg * 32 + cl; const size_t base = ((size_t)b * SEQ + chunk * 32) * DMOD + c4;
                f32x4 p = (f32x4){0.f, 0.f, 0.f, 0.f}, h = p;
#pragma unroll 16
                for (int t = 0; t < 32; ++t) { const v2u lw = *(const v2u*)(LAb + base + (size_t)t * DMOD), bw = *(const v2u*)(BB + base + (size_t)t * DMOD);
                    const f32x4 l = (f32x4){pg8::bf_lo(lw.x), pg8::bf_hi(lw.x), pg8::bf_lo(lw.y), pg8::bf_hi(lw.y)}, bb = (f32x4){pg8::bf_lo(bw.x), pg8::bf_hi(bw.x), pg8::bf_lo(bw.y), pg8::bf_hi(bw.y)};
                    const f32x4 a = (f32x4){pg8::fexp(l.x), pg8::fexp(l.y), pg8::fexp(l.z), pg8::fexp(l.w)}; h = a * h + bb; p += l; }
                *(LAS f32x4*)(cP + chunk * 32 + cl) = (f32x4){pg8::fexp(p.x), pg8::fexp(p.y), pg8::fexp(p.z), pg8::fexp(p.w)}; *(LAS f32x4*)(cH + chunk * 32 + cl) = h;
                __syncthreads();
                h = (f32x4){0.f, 0.f, 0.f, 0.f};
                for (int c = 0; c < chunk; ++c) h = *(const LAS f32x4*)(cP + c * 32 + cl) * h + *(const LAS f32x4*)(cH + c * 32 + cl);
#pragma unroll 16
                for (int t = 0; t < 32; ++t) { const v2u lw = *(const v2u*)(LAb + base + (size_t)t * DMOD), bw = *(const v2u*)(BB + base + (size_t)t * DMOD), gwd = *(const v2u*)(GB + base + (size_t)t * DMOD);
                    const f32x4 a = (f32x4){pg8::fexp(pg8::bf_lo(lw.x)), pg8::fexp(pg8::bf_hi(lw.x)), pg8::fexp(pg8::bf_lo(lw.y)), pg8::fexp(pg8::bf_hi(lw.y))};
                    h = a * h + (f32x4){pg8::bf_lo(bw.x), pg8::bf_hi(bw.x), pg8::bf_lo(bw.y), pg8::bf_hi(bw.y)};
                    v2u o; o.x = pk2(h.x * pg8::bf_lo(gwd.x), h.y * pg8::bf_hi(gwd.x)); o.y = pk2(h.z * pg8::bf_lo(gwd.y), h.w * pg8::bf_hi(gwd.y));
                    *(v2u*)(XPRE + base + (size_t)t * DMOD) = o; }
                __syncthreads(); } }
            XBAR();
            { PHASE_ARGS(); pg8::Gemm g{XPRE, WRGOUT, M, DMOD, DMOD, DMOD, DMOD, 0, 0}; pg8::StaticOrder S; S.init(M, DMOD, G, bx);
              pg8::EpiResid E{XB, A_->in[I_RGBOUT], 1.0f, SSQ(2)};
              if (EN_RES) pg8::gemm_phase<pg8::EpiResid, pg8::StaticOrder, true, true>(lds, g, S, E); }
            XBAR();
    FFN_STEP(W2IN, W2OUT, 2, SSQ(3), SLOT2);
            { PHASE_ARGS(); pg8::Gemm g{XB, WKV, M, 2048, DMOD, DMOD, DMOD, 0, 0}; pg8::StaticOrder S; S.init(M, 2048, G, bx);
              RTAB_FILL(S, SSQ(3), rs_); pg8::EpiKV E{KVb, cosT, sinT, rs_};
              if (EN_KV) pg8::gemm_phase<pg8::EpiKV, pg8::StaticOrder, true, true>(lds, g, S, E);
              if (PROBE == 5) pg8::gemm_phase<pg8::EpiKV, pg8::StaticOrder, true, true>(lds, g, S, E); }
    FFN_STEP(W1IN, W1OUT, 3, SSQ(4), SLOT3);
            { PHASE_ARGS(); pg8::Gemm g{XB, WQ, M, DMOD, DMOD, DMOD, DMOD, 0, 0}; pg8::StaticOrder S; S.init(M, DMOD, G, bx);
              RTAB_FILL(S, SSQ(4), rs_); pg8::EpiQ E{Qb, cosT, sinT, attn_body::C2, rs_};
              if (EN_Q) pg8::gemm_phase<pg8::EpiQ, pg8::StaticOrder, true, true>(lds, g, S, E);
              if (PROBE == 5) pg8::gemm_phase<pg8::EpiQ, pg8::StaticOrder, true, true>(lds, g, S, E); }
            XBAR();
            { PHASE_ARGS(); if (EN_ATT) attn_body::attn_phase<8>((char*)lds_raw, (const attn_body::bf16*)Qb, (const attn_body::bf16*)KVb, (attn_body::bf16*)Ob, vcu, G);
              if (PROBE == 2) attn_body::attn_phase<8>((char*)lds_raw, (const attn_body::bf16*)Qb, (const attn_body::bf16*)KVb, (attn_body::bf16*)Ob, vcu, G); }
            XBAR();
            if (EN_COMB) { PHASE_IDS(); const float* lp = A_->in[I_DLAM];
              const float s1 = wave_sum(lp[lane] * lp[64 + lane]), s2 = wave_sum(lp[128 + lane] * lp[192 + lane]);
              const float lam = __expf(s1) - __expf(s2) + LAMBDA_INIT;
              const int head = lane >> 3, dv0 = (lane & 7) * 16;
              float gsub[16];
#pragma unroll
              for (int i = 0; i < 16; ++i) gsub[i] = A_->in[I_SUBLN][dv0 + i] * (1.0f - LAMBDA_INIT);
              for (int rep9 = 0; rep9 < (PROBE == 9 ? 2 : 1); ++rep9) for (int m_ = gw; m_ < M; m_ += NGW) {
                  const bf16* o1p = Ob + (size_t)m_ * 2048 + head * 256 + dv0;
                  const v4u a0 = *(const v4u*)o1p, a1 = *(const v4u*)(o1p + 8), b0 = *(const v4u*)(o1p + 128), b1 = *(const v4u*)(o1p + 136);
                  float o[16];
#pragma unroll
                  for (int i = 0; i < 4; ++i) { o[2 * i] = pg8::bf_lo(a0[i]) - lam * pg8::bf_lo(b0[i]); o[2 * i + 1] = pg8::bf_hi(a0[i]) - lam * pg8::bf_hi(b0[i]);
                      o[8 + 2 * i] = pg8::bf_lo(a1[i]) - lam * pg8::bf_lo(b1[i]); o[8 + 2 * i + 1] = pg8::bf_hi(a1[i]) - lam * pg8::bf_hi(b1[i]); }
                  float ss = 0.f;
#pragma unroll
                  for (int i = 0; i < 16; ++i) ss += o[i] * o[i];
                  ss += __shfl_xor(ss, 1); ss += __shfl_xor(ss, 2); ss += __shfl_xor(ss, 4);
                  const float r = 1.0f / sqrtf(ss * (1.f / 128.f) + EPS);
                  v4u w0, w1;
#pragma unroll
                  for (int i = 0; i < 4; ++i) { w0[i] = pk2(o[2 * i] * r * gsub[2 * i], o[2 * i + 1] * r * gsub[2 * i + 1]); w1[i] = pk2(o[8 + 2 * i] * r * gsub[8 + 2 * i], o[9 + 2 * i] * r * gsub[9 + 2 * i]); }
                  bf16* op = Qb + (size_t)m_ * DMOD + head * 128 + dv0; *(v4u*)op = w0; *(v4u*)(op + 8) = w1; } }
            XBAR();
            { PHASE_ARGS(); pg8::Gemm g{Qb, WO, M, DMOD, DMOD, DMOD, DMOD, 0, 0}; pg8::StaticOrder S; S.init(M, DMOD, G, bx);
              pg8::EpiResid E{XB, nullptr, 1.0f, SSQ(5)};
              if (EN_RES) pg8::gemm_phase<pg8::EpiResid, pg8::StaticOrder, true, true>(lds, g, S, E); }
            XBAR();
    FFN_STEP(W2IN, W2OUT, 5, (float*)nullptr, SLOTNONE);
    { PHASE_IDS(); int m_ = gw;
      for (; m_ + NGW < M; m_ += 2 * NGW) rms_row2_out(XB + (size_t)m_ * DMOD, XB + (size_t)(m_ + NGW) * DMOD, A_->in[I_FINALN], H + (size_t)m_ * DMOD, H + (size_t)(m_ + NGW) * DMOD, lane);
      for (; m_ < M; m_ += NGW) rms_row_out(XB + (size_t)m_ * DMOD, A_->in[I_FINALN], H + (size_t)m_ * DMOD, lane); }
}

extern "C" void kernel_launch(void* const* d_in, const int* in_sizes, int n_in, void* d_out, int out_size, void* d_ws, size_t ws_size, hipStream_t stream) {
    static int grid = 0;
    if (grid == 0) {
        if (n_in != 24 || out_size != M * DMOD || ws_size < WS_END) { fprintf(stderr, "kernel_launch: unexpected shapes (n_in %d out %d ws %zu)\n", n_in, out_size, ws_size); grid = -1; return; }
        int dev = 0, cus = 0, per_cu = 0;
        hipGetDevice(&dev); hipDeviceGetAttribute(&cus, hipDeviceAttributeMultiprocessorCount, dev);
        if (hipFuncSetAttribute((const void*)fwd_mega, hipFuncAttributeMaxDynamicSharedMemorySize, LDS_BYTES) != hipSuccess) { fprintf(stderr, "kernel_launch: hipFuncSetAttribute failed\n"); grid = -1; return; }
        if (hipOccupancyMaxActiveBlocksPerMultiprocessor(&per_cu, (const void*)fwd_mega, NTHR, LDS_BYTES) != hipSuccess || per_cu < 1) { fprintf(stderr, "kernel_launch: occupancy query says %d\n", per_cu); per_cu = 1; }
        (void)hipGetLastError();
        grid = cus * 1;
    }
    if (grid < 0) return;
    if (hipMemsetAsync((char*)d_ws + WS_BAR, 0, BAR_BYTES, stream) != hipSuccess) { fprintf(stderr, "kernel_launch: memset failed\n"); return; }
    Args a{};
    for (int i = 0; i < 24; ++i) a.in[i] = (const float*)d_in[i];
    a.out = (float*)d_out; a.ws = (unsigned char*)d_ws;
    void* kargs[] = {&a};
    hipError_t e = hipLaunchCooperativeKernel((const void*)fwd_mega, dim3(grid), dim3(NTHR), kargs, LDS_BYTES, stream);
    if (e != hipSuccess) fprintf(stderr, "cooperative launch failed: %s (grid %d)\n", hipGetErrorString(e), grid);
}
```
